# Optimizing an MI355X kernel written in HIP

```python
import jax
import jax.numpy as jnp
from jax import lax
import numpy as np

D_MODEL = 1024
BATCH = 8
SEQ = 4096
DEPTH = 4

MEM_LEN = 256
D_FF = 2816
FFN_RES = 0.5
EPS = 1e-6
MIX_W = D_MODEL
CONV_W = D_MODEL // 4
CONV_LEN = 3
HG_HEAD_DIM = 64
HG_W = 3 * D_MODEL // 8
HG_HEADS = HG_W // HG_HEAD_DIM
HG_EXP_CLIP = 80.0
RW_HEAD_DIM = 64
RW_W = MIX_W - CONV_W - HG_W
RW_HEADS = RW_W // RW_HEAD_DIM
RW_DECAY_RANK = 64
RW_A_RANK = 64
RW_G_RANK = 128
RW_PROJ = 3 * RW_W + RW_DECAY_RANK + RW_A_RANK + RW_G_RANK
RW_SPLITS = (RW_W, 2 * RW_W, 3 * RW_W, 3 * RW_W + RW_DECAY_RANK, 3 * RW_W + RW_DECAY_RANK + RW_A_RANK)
RW_DECAY_SCALE = 0.606531
RW_GN_EPS = 64e-5
CONV_PROJ = 3 * CONV_W
HG_PROJ = 4 * HG_W
IN_W = CONV_PROJ + HG_PROJ + RW_PROJ
CHUNK = 64
XA_HEADS = 4
XA_HEAD_DIM = D_MODEL // XA_HEADS

kernel_name = 'hybrid_conv_hgrn2_rwkv7_macaron_memxattn'


def rmsnorm(x, g):
    xf = x.astype(jnp.float32)
    xf = xf * lax.rsqrt(jnp.mean(xf * xf, axis=-1, keepdims=True) + EPS)
    return (xf * g.astype(jnp.float32)).astype(x.dtype)


def swiglu_ffn(x, w_in, w_out):
    gate, up = jnp.split(x @ w_in, 2, axis=-1)
    return (jax.nn.silu(gate) * up) @ w_out


def short_conv_mixer(p, conv_w, conv_b):
    b_gate, c_gate, x_in = jnp.split(p, 3, axis=-1)
    z = c_gate * x_in
    zc = lax.conv_general_dilated(
        z, conv_w[:, None, :], window_strides=(1,), padding=[(CONV_LEN - 1, 0)],
        dimension_numbers=('NWC', 'WIO', 'NWC'), feature_group_count=CONV_W)
    return b_gate * (zc + conv_b)


def hgrn2_mixer(p, lb, norm_g):
    bsz, seqlen, _ = p.shape
    n_chunks = seqlen // CHUNK
    f32 = jnp.float32
    q, f_logit, i_in, g = jnp.split(p.astype(f32), 4, axis=-1)
    log_f = jax.nn.log_sigmoid(f_logit) + jnp.log1p(lb * jnp.exp(jnp.minimum(-f_logit, HG_EXP_CLIP)))
    k = (1.0 - lb) * jax.nn.sigmoid(-f_logit)
    q = jax.nn.silu(q)

    def to_chunks(t):
        return t.reshape(bsz, n_chunks, CHUNK, HG_HEADS, -1).transpose(1, 0, 3, 2, 4)

    causal = jnp.tril(jnp.ones((CHUNK, CHUNK), dtype=bool))[:, :, None]

    def chunk_step(state, inp):
        qc, kc, vc, lfc = inp
        b = jnp.cumsum(lfc, axis=2)
        o_inter = jnp.einsum('bhtd,bhde->bhte', qc * jnp.exp(b), state)
        diff = b[:, :, :, None, :] - b[:, :, None, :, :]
        dec = jnp.where(causal, jnp.exp(jnp.minimum(diff, 0.0)), 0.0)
        att = jnp.einsum('bhtd,bhsd,bhtsd->bhts', qc, kc, dec)
        o = o_inter + jnp.einsum('bhts,bhse->bhte', att, vc)
        b_last = b[:, :, -1:, :]
        state = (jnp.exp(b_last[:, :, 0, :])[..., None] * state
                 + jnp.einsum('bhsd,bhse->bhde', kc * jnp.exp(b_last - b), vc))
        return state, o

    state0 = jnp.zeros((bsz, HG_HEADS, HG_HEAD_DIM, HG_HEAD_DIM), f32)
    _, o = lax.scan(chunk_step, state0,
                    (to_chunks(q), to_chunks(k), to_chunks(i_in), to_chunks(log_f)))
    o = o.transpose(1, 0, 3, 2, 4).reshape(bsz, seqlen, HG_HEADS, HG_HEAD_DIM)
    o = o * lax.rsqrt(jnp.mean(o * o, axis=-1, keepdims=True) + EPS)
    o = o.reshape(bsz, seqlen, HG_W) * norm_g.astype(f32) * jax.nn.silu(g)
    return o.astype(p.dtype)


def rwkv7_mixer(p, mu, w0, w2, a0, a2, g2, k_k, k_a, r_k, ln_w, ln_b):
    bsz, seqlen, _ = p.shape
    f32 = jnp.float32
    cast = lambda t: t.astype(f32)
    pf = cast(p)
    p_prev = jnp.pad(pf, ((0, 0), (1, 0), (0, 0)))[:, :-1]
    pf = pf + (p_prev - pf) * cast(mu)
    r, k, v, wd, ad, gd = jnp.split(pf, RW_SPLITS, axis=-1)
    log_w = -RW_DECAY_SCALE * jax.nn.sigmoid(cast(w0) + jnp.tanh(wd) @ cast(w2))
    a = jax.nn.sigmoid(cast(a0) + ad @ cast(a2))
    g = jax.nn.sigmoid(gd) @ cast(g2)
    heads = lambda t: t.reshape(bsz, seqlen, RW_HEADS, RW_HEAD_DIM)
    kk = heads(k * cast(k_k))
    kk = kk / jnp.maximum(jnp.sqrt(jnp.sum(kk * kk, axis=-1, keepdims=True)), 1e-12)
    k = k * (1.0 + (a - 1.0) * cast(k_a))
    rh, kh, vh = heads(r), heads(k), heads(v)
    a_vec = -kk
    b_vec = kk * heads(a)
    tm = lambda t: jnp.swapaxes(t, 0, 1)

    def step(state, inp):
        r_t, w_t, k_t, v_t, a_t, b_t = inp
        sa = jnp.einsum('bhij,bhj->bhi', state, a_t)
        state = (state * w_t[:, :, None, :] + sa[..., None] * b_t[:, :, None, :]
                 + v_t[..., None] * k_t[:, :, None, :])
        return state, jnp.einsum('bhij,bhj->bhi', state, r_t)

    state0 = jnp.zeros((bsz, RW_HEADS, RW_HEAD_DIM, RW_HEAD_DIM), f32)
    _, y = lax.scan(step, state0, (tm(rh), tm(heads(jnp.exp(log_w))), tm(kh), tm(vh), tm(a_vec), tm(b_vec)))
    y = jnp.swapaxes(y, 0, 1)
    mean = jnp.mean(y, axis=-1, keepdims=True)
    var = jnp.mean(jnp.square(y - mean), axis=-1, keepdims=True)
    y = ((y - mean) * lax.rsqrt(var + RW_GN_EPS)).reshape(bsz, seqlen, RW_W) * cast(ln_w) + cast(ln_b)
    bonus = jnp.sum(rh * kh * cast(r_k), axis=-1, keepdims=True) * vh
    out = (y + bonus.reshape(bsz, seqlen, RW_W)) * g
    return out.astype(p.dtype)


def memory_cross_attention(h_n, mem_n, wq, wkv, wo):
    bsz, seqlen, _ = h_n.shape
    q = (h_n @ wq).reshape(bsz, seqlen, XA_HEADS, XA_HEAD_DIM)
    mk, mv = jnp.split(mem_n @ wkv, 2, axis=-1)
    mk = mk.reshape(bsz, -1, XA_HEADS, XA_HEAD_DIM)
    mv = mv.reshape(bsz, -1, XA_HEADS, XA_HEAD_DIM)
    s = jnp.einsum('bshd,bmhd->bhsm', q, mk).astype(jnp.float32) * (XA_HEAD_DIM ** -0.5)
    pr = jax.nn.softmax(s, axis=-1).astype(mv.dtype)
    o = jnp.einsum('bhsm,bmhd->bshd', pr, mv).reshape(bsz, seqlen, D_MODEL)
    return o @ wo


def setup_inputs(seed: int = 0) -> dict:
    key = jax.random.key(seed)
    ks = iter(jax.random.split(key, 40))
    nrm = lambda shape, scale: jax.random.normal(next(ks), shape, jnp.float32) * scale
    gain = lambda shape: 1.0 + nrm(shape, 0.02)
    L, D = DEPTH, D_MODEL
    return {
        'x': nrm((BATCH, SEQ, D), 1.0),
        'mem': nrm((BATCH, MEM_LEN, D), 1.0),
        'ffn1_norm': gain((L, D)),
        'ffn1_w_in': nrm((L, D, 2 * D_FF), D ** -0.5),
        'ffn1_w_out': nrm((L, D_FF, D), D_FF ** -0.5),
        'mix_norm': gain((L, D)),
        'w_mix_in': nrm((L, D, IN_W), D ** -0.5),
        'w_mix_out': nrm((L, MIX_W, D), MIX_W ** -0.5),
        'conv_w': nrm((L, CONV_LEN, CONV_W), CONV_LEN ** -0.5),
        'conv_b': nrm((L, CONV_W), 0.02),
        'hgrn_lb_logits': nrm((L, HG_W), 0.1),
        'hgrn_norm': gain((L, HG_W)),
        'rwkv_mu': jax.random.uniform(next(ks), (L, RW_PROJ), jnp.float32),
        'rwkv_w0': nrm((L, RW_W), 0.5),
        'rwkv_w2': nrm((L, RW_DECAY_RANK, RW_W), RW_DECAY_RANK ** -0.5),
        'rwkv_a0': nrm((L, RW_W), 0.1),
        'rwkv_a2': nrm((L, RW_A_RANK, RW_W), RW_A_RANK ** -0.5),
        'rwkv_g2': nrm((L, RW_G_RANK, RW_W), RW_G_RANK ** -0.5),
        'rwkv_k_k': 0.85 + nrm((L, RW_W), 0.05),
        'rwkv_k_a': 1.0 + nrm((L, RW_W), 0.05),
        'rwkv_r_k': nrm((L, RW_HEADS, RW_HEAD_DIM), 0.1),
        'rwkv_ln_w': gain((L, RW_W)),
        'rwkv_ln_b': nrm((L, RW_W), 0.02),
        'xattn_norm': gain((L, D)),
        'mem_norm': gain((L, D)),
        'xattn_wq': nrm((L, D, D), D ** -0.5),
        'xattn_wkv': nrm((L, D, 2 * D), D ** -0.5),
        'xattn_wo': nrm((L, D, D), D ** -0.5),
        'ffn2_norm': gain((L, D)),
        'ffn2_w_in': nrm((L, D, 2 * D_FF), D ** -0.5),
        'ffn2_w_out': nrm((L, D_FF, D), D_FF ** -0.5),
        'final_norm': gain((D,)),
    }


def reference(x, mem, ffn1_norm, ffn1_w_in, ffn1_w_out, mix_norm, w_mix_in, w_mix_out,
              conv_w, conv_b, hgrn_lb_logits, hgrn_norm, rwkv_mu, rwkv_w0, rwkv_w2, rwkv_a0,
              rwkv_a2, rwkv_g2, rwkv_k_k, rwkv_k_a, rwkv_r_k, rwkv_ln_w, rwkv_ln_b,
              xattn_norm, mem_norm, xattn_wq, xattn_wkv, xattn_wo,
              ffn2_norm, ffn2_w_in, ffn2_w_out, final_norm):
    lb_sm = jax.nn.softmax(hgrn_lb_logits.astype(jnp.float32), axis=0)
    lb_all = jnp.maximum(jnp.cumsum(lb_sm, axis=0) - lb_sm[0], 0.0)
    h = x
    for l in range(DEPTH):
        h = h + FFN_RES * swiglu_ffn(rmsnorm(h, ffn1_norm[l]), ffn1_w_in[l], ffn1_w_out[l])
        u = rmsnorm(h, mix_norm[l])
        p = u @ w_mix_in[l]
        p_conv, p_hg, p_rw = jnp.split(p, (CONV_PROJ, CONV_PROJ + HG_PROJ), axis=-1)
        y = jnp.concatenate([
            short_conv_mixer(p_conv, conv_w[l], conv_b[l]),
            hgrn2_mixer(p_hg, lb_all[l], hgrn_norm[l]),
            rwkv7_mixer(p_rw, rwkv_mu[l], rwkv_w0[l], rwkv_w2[l], rwkv_a0[l], rwkv_a2[l],
                        rwkv_g2[l], rwkv_k_k[l], rwkv_k_a[l], rwkv_r_k[l], rwkv_ln_w[l], rwkv_ln_b[l]),
        ], axis=-1)
        h = h + y @ w_mix_out[l]
        h = h + memory_cross_attention(rmsnorm(h, xattn_norm[l]), rmsnorm(mem, mem_norm[l]),
                                       xattn_wq[l], xattn_wkv[l], xattn_wo[l])
        h = h + FFN_RES * swiglu_ffn(rmsnorm(h, ffn2_norm[l]), ffn2_w_in[l], ffn2_w_out[l])
    return rmsnorm(h, final_norm)
```

```cpp
#include <hip/hip_runtime.h>
#include <hip/hip_cooperative_groups.h>
#include <cstdio>
namespace cg = cooperative_groups;

#ifndef MK_PER_PHASE_LAUNCH
#define MK_PER_PHASE_LAUNCH 0
#endif

#ifndef DUP_K
#define DUP_K -1
#endif
#ifndef DUP_SYNC
#define DUP_SYNC 0
#endif
#define LAS __attribute__((address_space(3)))
typedef unsigned short bf16_t;
typedef short bf16x8 __attribute__((ext_vector_type(8)));
typedef float f32x4 __attribute__((ext_vector_type(4)));
typedef float f32x2 __attribute__((ext_vector_type(2)));
typedef unsigned u32x4 __attribute__((ext_vector_type(4)));
typedef unsigned u32x2 __attribute__((ext_vector_type(2)));

constexpr int T = 32768, D = 1024, SEQ = 4096, DFF = 2816, NL = 4;
constexpr int MT = 2048;
constexpr int INW = 3712, INWP = 3840;
constexpr int PC_HG = 768, PC_RW = 2304;
constexpr int LRW = 1152, LRWP = 1280;
constexpr float EPS = 1e-6f;

constexpr size_t W_FFN1_IN = 0;
constexpr size_t W_FFN1_OUT = W_FFN1_IN + (size_t)5632 * 1024 * 2;
constexpr size_t W_MIX_IN = W_FFN1_OUT + (size_t)1024 * 2816 * 2;
constexpr size_t W_LR = W_MIX_IN + (size_t)INWP * 1024 * 2;
constexpr size_t W_MIX_OUT = W_LR + (size_t)LRWP * 256 * 2;
constexpr size_t W_Q = W_MIX_OUT + (size_t)1024 * 1024 * 2;
constexpr size_t W_O = W_Q + (size_t)1024 * 1024 * 2;
constexpr size_t W_FFN2_IN = W_O + (size_t)1024 * 1024 * 2;
constexpr size_t W_FFN2_OUT = W_FFN2_IN + (size_t)5632 * 1024 * 2;
constexpr size_t W_END = W_FFN2_OUT + (size_t)1024 * 2816 * 2;
constexpr size_t WS_HB = W_END;
constexpr size_t WS_S1 = WS_HB + (size_t)T * 1024 * 2;
constexpr size_t S1_BYTES = (size_t)T * INW * 2;
constexpr size_t WS_LRIN = WS_S1 + S1_BYTES;
constexpr size_t WS_LROUT = WS_LRIN + (size_t)T * 256 * 2;
constexpr size_t WS_YQ = WS_LROUT + (size_t)T * LRW * 2;
constexpr size_t WS_KALL = WS_YQ + (size_t)T * 1024 * 2;
constexpr size_t WS_VT = WS_KALL + (size_t)NL * MT * 1024 * 2;
constexpr size_t WS_SSQ = WS_VT + (size_t)NL * MT * 1024 * 2;
constexpr size_t WS_CTL = WS_SSQ + (size_t)T * 16 * 4;
constexpr size_t CTL_BYTES = 16384;
constexpr size_t WS_LB = WS_CTL + CTL_BYTES;
constexpr size_t WS_END = WS_LB + 8192;
constexpr size_t S1_O = (size_t)T * 1024 * 2;
constexpr size_t S1_WKV = 0, S1_MEMH = (size_t)8192 * 1024 * 2;

constexpr int LDS_STAGE = 131072, LDS_XCH = 131072, LDS_MISC = 131072 + 8192, LDS_PRE = 131072 + 8192 + 256, LDS_BYTES = LDS_PRE + 16384;
constexpr int NPH = 2 + 12 * NL + 1;

__device__ __forceinline__ int opaque_tid() { int t = threadIdx.x; asm volatile("" : "+v"(t)); return t; }
__device__ __forceinline__ unsigned f2bf(float f) { unsigned u = __float_as_uint(f); return (u + 0x7fffu + ((u >> 16) & 1u)) >> 16; }
__device__ __forceinline__ unsigned pk2(float lo, float hi) { return f2bf(lo) | (f2bf(hi) << 16); }
__device__ __forceinline__ unsigned cvt_pk(float lo, float hi) { unsigned r; asm volatile("v_cvt_pk_bf16_f32 %0, %1, %2" : "=v"(r) : "v"(lo), "v"(hi)); return r; }
__device__ __forceinline__ float bflo(unsigned w) { return __uint_as_float(w << 16); }
__device__ __forceinline__ float bfhi(unsigned w) { return __uint_as_float(w & 0xffff0000u); }
__device__ __forceinline__ float bf1(const bf16_t* p) { return __uint_as_float(((unsigned)*p) << 16); }
__device__ __forceinline__ float sigm(float x) { return __builtin_amdgcn_rcpf(1.0f + __expf(-x)); }
__device__ __forceinline__ float silu(float x) { return x * sigm(x); }
__device__ __forceinline__ float tanh_f(float x) { return 1.0f - 2.0f * __builtin_amdgcn_rcpf(__expf(2.0f * x) + 1.0f); }
__device__ __forceinline__ float wave_sum(float v) {
#pragma unroll
    for (int o = 1; o < 64; o <<= 1) v += __shfl_xor(v, o);
    return v;
}
template <int CTRL> __device__ __forceinline__ float dppf(float v) { return __int_as_float(__builtin_amdgcn_update_dpp(0, __float_as_int(v), CTRL, 0xF, 0xF, true)); }
__device__ __forceinline__ float sum16(float x) {
    x += dppf<0xB1>(x);
    x += dppf<0x4E>(x);
    x += dppf<0x124>(x);
    x += dppf<0x128>(x);
    return x;
}
__device__ __forceinline__ void sum16x2(float& a, float& b) {
    a += dppf<0xB1>(a); b += dppf<0xB1>(b); a += dppf<0x4E>(a); b += dppf<0x4E>(b);
    a += dppf<0x124>(a); b += dppf<0x124>(b); a += dppf<0x128>(a); b += dppf<0x128>(b);
}
__device__ __forceinline__ float reduce_scatter16(const float (&p)[16], int q, bool up4) {
    const bool b0 = (q & 1) != 0, b1 = (q & 2) != 0, b2 = (q & 4) != 0, b3 = (q & 8) != 0;
    float r[8], u[4], w[2];
#pragma unroll
    for (int i = 0; i < 8; ++i) { const float keep = b0 ? p[2 * i + 1] : p[2 * i], send = b0 ? p[2 * i] : p[2 * i + 1]; r[i] = keep + dppf<0xB1>(send); }
#pragma unroll
    for (int i = 0; i < 4; ++i) { const float keep = b1 ? r[2 * i + 1] : r[2 * i], send = b1 ? r[2 * i] : r[2 * i + 1]; u[i] = keep + dppf<0x4E>(send); }
#pragma unroll
    for (int i = 0; i < 2; ++i) { const float keep = b3 ? u[2 + i] : u[i], send = b3 ? u[i] : u[2 + i]; w[i] = keep + dppf<0x128>(send); }
    const float keep = b2 ? w[1] : w[0], send = b2 ? w[0] : w[1];
    const float r4 = dppf<0x124>(send), r12 = dppf<0x12C>(send);
    return keep + (up4 ? r4 : r12);
}
__device__ __forceinline__ void rstd8_load(const float* ssq, int row0, int fq, float (&pre)[2][4]) {
#pragma unroll
    for (int ai = 0; ai < 2; ++ai)
#pragma unroll
        for (int m = 0; m < 4; ++m) pre[ai][m] = ssq[(size_t)(row0 + ai * 128 + m * 16) * 4 + fq];
}
__device__ __forceinline__ void rstd8_finish(const float (&pre)[2][4], float (&rsv)[2][4]) {
#pragma unroll
    for (int ai = 0; ai < 2; ++ai)
#pragma unroll
        for (int m = 0; m < 4; ++m) {
            float sm = pre[ai][m];
            sm += __shfl_xor(sm, 16); sm += __shfl_xor(sm, 32);
            rsv[ai][m] = rsqrtf(sm * (1.0f / 1024.0f) + EPS);
        }
}

constexpr int BM = 256, BK = 64, HALF = 128, HTB = HALF * BK * 2, NXCD = 8, WGM = 8;
__device__ __forceinline__ int lds_byte(int r, int c) { const int st = (r >> 4) * 2 + (c >> 5), rr = r & 15, cc = c & 31, ob = rr * 64 + cc * 2; return st * 1024 + (ob ^ (((ob >> 9) & 1) << 5)); }
__device__ __forceinline__ void stage_rc(int b, int& R, int& C) { const int st = b / 1024, sb = b % 1024, swz = sb ^ (((sb >> 9) & 1) << 5); R = (st >> 1) * 16 + swz / 64; C = (st & 1) * 32 + (swz % 64) / 2; }
__device__ __forceinline__ int perm32(int rho) { const int n = rho >> 4, i = rho & 15; return 8 * (i >> 2) + 4 * n + (i & 3); }

struct Unit { int pm, pn; };
struct Gemm { const bf16_t* A; const bf16_t* Bt; int M, N, K, lda, ldb; unsigned aHi, aLo, aPn, bPn, bHi, bLo; int aSh, aMsk, bSh, bMsk; };
struct Sched {
    int nM, nN, nwg, G, c;
    __device__ __forceinline__ void init(int M, int N, int G_, int c_) { nM = M / BM; nN = N / BM; nwg = nM * nN; G = G_; c = c_; }
    __device__ __forceinline__ bool next(int i, Unit& u) const {
        const long L = (long)i * G + c; if (L >= nwg) return false;
        int wgid = (int)L; { const int q = nwg / NXCD, r = nwg % NXCD, xcd = wgid % NXCD, off = wgid / NXCD; wgid = (xcd < r ? xcd * (q + 1) : r * (q + 1) + (xcd - r) * q) + off; }
        const int nig = WGM * nN, gid = wgid / nig, fm = gid * WGM, gsz = (nM - fm) < WGM ? (nM - fm) : WGM;
        u.pm = fm + ((wgid % nig) % gsz); u.pn = (wgid % nig) / gsz; return true;
    }
};

typedef f32x4 Acc[2][2][4][2];

struct EpiBf16S {
    static constexpr bool PERM = true, RSTD = true;
    bf16_t* O; int ldc, ncols; const float* ssq; int mode; const float* lb;
    __device__ __forceinline__ const float* pre_src(const Unit& u, int wr, int fr, int fq) const { return ssq ? ssq + (size_t)(u.pm * BM + wr * 64 + fr) * 4 + fq : nullptr; }
    __device__ __forceinline__ void operator()(const Acc& acc, const Unit& u, int wr, int wc, int fr, int fq, const float (&pre)[2][4]) const {
        const int row0 = u.pm * BM + wr * 64 + fr, col0 = u.pn * BM + wc * 32 + 8 * fq;
        float rsv[2][4];
        if (ssq) rstd8_finish(pre, rsv);
        else {
#pragma unroll
            for (int ai = 0; ai < 2; ++ai)
#pragma unroll
                for (int m = 0; m < 4; ++m) rsv[ai][m] = 1.0f;
        }
#pragma unroll
        for (int bj = 0; bj < 2; ++bj) {
            const int cb = u.pn * BM + bj * HALF;
            if (cb >= ncols) continue;
            int type = 0;
            f32x4 l0 = (f32x4){0.f, 0.f, 0.f, 0.f}, l1 = l0;
            if (mode == 1) {
                if ((cb >= 768 && cb < 1152) || (cb >= 1920 && cb < 2304)) type = 1;
                else if (cb >= 1152 && cb < 1536) { type = 2; l0 = *(const f32x4*)(lb + col0 + bj * HALF - 1152); l1 = *(const f32x4*)(lb + col0 + bj * HALF - 1152 + 4); }
            }
#pragma unroll
            for (int ai = 0; ai < 2; ++ai)
#pragma unroll
                for (int m = 0; m < 4; ++m) {
                    const int row = row0 + ai * HALF + m * 16;
                    const float rs = rsv[ai][m];
                    f32x4 v0 = acc[ai][bj][m][0] * rs, v1 = acc[ai][bj][m][1] * rs;
                    if (type == 1) {
#pragma unroll
                        for (int j = 0; j < 4; ++j) { v0[j] = silu(v0[j]); v1[j] = silu(v1[j]); }
                    } else if (type == 2) {
#pragma unroll
                        for (int j = 0; j < 4; ++j) { v0[j] = (1.0f - l0[j]) * sigm(-v0[j]); v1[j] = (1.0f - l1[j]) * sigm(-v1[j]); }
                    }
                    u32x4 w; w.x = cvt_pk(v0[0], v0[1]); w.y = cvt_pk(v0[2], v0[3]); w.z = cvt_pk(v1[0], v1[1]); w.w = cvt_pk(v1[2], v1[3]);
                    *(u32x4*)(O + (size_t)row * ldc + col0 + bj * HALF) = w;
                }
        }
    }
};
struct EpiSwiglu {
    static constexpr bool PERM = true, RSTD = true;
    bf16_t* O; const float* ssq;
    __device__ __forceinline__ const float* pre_src(const Unit& u, int wr, int fr, int fq) const { return ssq ? ssq + (size_t)(u.pm * BM + wr * 64 + fr) * 4 + fq : nullptr; }
    __device__ __forceinline__ void operator()(const Acc& acc, const Unit& u, int wr, int wc, int fr, int fq, const float (&pre)[2][4]) const {
        const int row0 = u.pm * BM + wr * 64 + fr, col0 = u.pn * HALF + wc * 32 + 8 * fq;
        float rsv[2][4];
        rstd8_finish(pre, rsv);
#pragma unroll
        for (int ai = 0; ai < 2; ++ai)
#pragma unroll
            for (int m = 0; m < 4; ++m) {
                const int row = row0 + ai * HALF + m * 16;
                const float rs = rsv[ai][m];
                float o[8];
#pragma unroll
                for (int n = 0; n < 2; ++n)
#pragma unroll
                    for (int j = 0; j < 4; ++j) { const float g = acc[ai][0][m][n][j] * rs, up = acc[ai][1][m][n][j] * rs; o[n * 4 + j] = silu(g) * up; }
                u32x4 w; w.x = cvt_pk(o[0], o[1]); w.y = cvt_pk(o[2], o[3]); w.z = cvt_pk(o[4], o[5]); w.w = cvt_pk(o[6], o[7]);
                *(u32x4*)(O + (size_t)row * DFF + col0) = w;
            }
    }
};
struct EpiResid {
    static constexpr bool PERM = true, RSTD = false;
    bf16_t* hb; float* ssq; float alpha; LAS unsigned char* lds;
    __device__ __forceinline__ void operator()(const Acc& acc, const Unit& u, int wr, int wc, int fr, int fq, const float (&pre)[2][4]) const {
        const int row0 = u.pm * BM + wr * 64 + fr, col0 = u.pn * BM + wc * 32 + 8 * fq;
        u32x4 h0w[4][2], h1w[4][2]; float ss0[4], ss1[4];
        LAS float* X = (LAS float*)(lds + LDS_XCH);
#pragma unroll
        for (int m = 0; m < 4; ++m)
#pragma unroll
            for (int bj = 0; bj < 2; ++bj) h0w[m][bj] = *(const u32x4*)(hb + (size_t)(row0 + m * 16) * D + col0 + bj * HALF);
#define RESID_COMPUTE(HW, SS, AI) _Pragma("unroll") for (int m = 0; m < 4; ++m) { float ss = 0.f; _Pragma("unroll") for (int bj = 0; bj < 2; ++bj) { const u32x4 w0 = HW[m][bj]; \
            f32x4 a0 = (f32x4){bflo(w0.x), bfhi(w0.x), bflo(w0.y), bfhi(w0.y)}, a1 = (f32x4){bflo(w0.z), bfhi(w0.z), bflo(w0.w), bfhi(w0.w)}; \
            a0 = a0 + acc[AI][bj][m][0] * alpha; a1 = a1 + acc[AI][bj][m][1] * alpha; \
            ss += ((a0[0] * a0[0] + a0[1] * a0[1]) + (a0[2] * a0[2] + a0[3] * a0[3])) + ((a1[0] * a1[0] + a1[1] * a1[1]) + (a1[2] * a1[2] + a1[3] * a1[3])); \
            u32x4 w; w.x = cvt_pk(a0[0], a0[1]); w.y = cvt_pk(a0[2], a0[3]); w.z = cvt_pk(a1[0], a1[1]); w.w = cvt_pk(a1[2], a1[3]); HW[m][bj] = w; } SS[m] = ss; }
#define RESID_STORE(HW, SS, AI) _Pragma("unroll") for (int m = 0; m < 4; ++m) { const int row = row0 + AI * HALF + m * 16; \
            _Pragma("unroll") for (int bj = 0; bj < 2; ++bj) *(u32x4*)(hb + (size_t)row * D + col0 + bj * HALF) = HW[m][bj]; \
            float ss = SS[m]; ss += __shfl_xor(ss, 16); ss += __shfl_xor(ss, 32); if (fq == 0) X[(AI * HALF + wr * 64 + m * 16 + fr) * 4 + wc] = ss; }
        RESID_COMPUTE(h0w, ss0, 0)
        asm volatile("" ::: "memory");
#pragma unroll
        for (int m = 0; m < 4; ++m)
#pragma unroll
            for (int bj = 0; bj < 2; ++bj) h1w[m][bj] = *(const u32x4*)(hb + (size_t)(row0 + HALF + m * 16) * D + col0 + bj * HALF);
        asm volatile("" ::: "memory");
        RESID_STORE(h0w, ss0, 0)
        RESID_COMPUTE(h1w, ss1, 1)
        RESID_STORE(h1w, ss1, 1)
#undef RESID_COMPUTE
#undef RESID_STORE
        asm volatile("s_waitcnt lgkmcnt(0)" ::: "memory"); __builtin_amdgcn_s_barrier(); asm volatile("" ::: "memory");
        if (fq == 0) {
#pragma unroll
            for (int ai = 0; ai < 2; ++ai) {
                const int rl = ai * HALF + wr * 64 + wc * 16 + fr;
                const f32x4 x = *(const LAS f32x4*)(X + rl * 4);
                ssq[(size_t)(u.pm * BM + rl) * 4 + u.pn] = (x.x + x.y) + (x.z + x.w);
            }
        }
    }
};
struct EpiLowrank {
    static constexpr bool PERM = true, RSTD = false;
    bf16_t* O; const float* w0; const float* a0;
    __device__ __forceinline__ void operator()(const Acc& acc, const Unit& u, int wr, int wc, int fr, int fq, const float (&pre)[2][4]) const {
        const int row0 = u.pm * BM + wr * 64 + fr;
#pragma unroll
        for (int bj = 0; bj < 2; ++bj) {
            const int cb = u.pn * BM + bj * HALF;
            if (cb >= LRW) continue;
            const int type = cb / 384, col0 = cb + wc * 32 + 8 * fq;
            f32x4 b0 = (f32x4){0.f, 0.f, 0.f, 0.f}, b1 = b0;
            if (type == 0) { b0 = *(const f32x4*)(w0 + col0); b1 = *(const f32x4*)(w0 + col0 + 4); }
            if (type == 1) { b0 = *(const f32x4*)(a0 + col0 - 384); b1 = *(const f32x4*)(a0 + col0 - 384 + 4); }
#pragma unroll
            for (int ai = 0; ai < 2; ++ai)
#pragma unroll
                for (int m = 0; m < 4; ++m) {
                    const int row = row0 + ai * HALF + m * 16;
                    f32x4 v0 = acc[ai][bj][m][0] + b0, v1 = acc[ai][bj][m][1] + b1;
                    if (type == 0) {
#pragma unroll
                        for (int j = 0; j < 4; ++j) { v0[j] = -0.606531f * sigm(v0[j]); v1[j] = -0.606531f * sigm(v1[j]); }
                    } else if (type == 1) {
#pragma unroll
                        for (int j = 0; j < 4; ++j) { v0[j] = sigm(v0[j]); v1[j] = sigm(v1[j]); }
                    }
                    u32x4 w; w.x = cvt_pk(v0[0], v0[1]); w.y = cvt_pk(v0[2], v0[3]); w.z = cvt_pk(v1[0], v1[1]); w.w = cvt_pk(v1[2], v1[3]);
                    *(u32x4*)(O + (size_t)row * LRW + col0) = w;
                }
        }
    }
};
struct EpiSoftmax {
    static constexpr bool PERM = true, RSTD = true;
    bf16_t* O; LAS unsigned char* lds; const float* ssq;
    __device__ __forceinline__ const float* pre_src(const Unit& u, int wr, int fr, int fq) const { return ssq ? ssq + (size_t)(u.pm * BM + wr * 64 + fr) * 4 + fq : nullptr; }
    __device__ __forceinline__ void operator()(const Acc& acc, const Unit& u, int wr, int wc, int fr, int fq, const float (&pre)[2][4]) const {
        LAS f32x2* X = (LAS f32x2*)(lds + LDS_XCH);
        const int row0 = u.pm * BM + wr * 64 + fr, col0 = u.pn * BM + wc * 32 + 8 * fq;
        float rsv[2][4];
        rstd8_finish(pre, rsv);
#pragma unroll
        for (int ai = 0; ai < 2; ++ai)
#pragma unroll
            for (int m = 0; m < 4; ++m) {
                const float rs = rsv[ai][m];
                float mx = -3.0e38f;
#pragma unroll
                for (int bj = 0; bj < 2; ++bj)
#pragma unroll
                    for (int n = 0; n < 2; ++n) { const f32x4 x = acc[ai][bj][m][n] * rs; mx = fmaxf(mx, fmaxf(fmaxf(x[0], x[1]), fmaxf(x[2], x[3]))); }
                mx = fmaxf(mx, __shfl_xor(mx, 16)); mx = fmaxf(mx, __shfl_xor(mx, 32));
                float l = 0.f;
#pragma unroll
                for (int bj = 0; bj < 2; ++bj)
#pragma unroll
                    for (int n = 0; n < 2; ++n) { const f32x4 x = acc[ai][bj][m][n] * rs; l += (__expf(x[0] - mx) + __expf(x[1] - mx)) + (__expf(x[2] - mx) + __expf(x[3] - mx)); }
                l += __shfl_xor(l, 16); l += __shfl_xor(l, 32);
                if (fq == 0) X[(ai * HALF + wr * 64 + m * 16 + fr) * 4 + wc] = (f32x2){mx, l};
            }
        asm volatile("s_waitcnt lgkmcnt(0)" ::: "memory"); __builtin_amdgcn_s_barrier(); asm volatile("" ::: "memory");
#pragma unroll
        for (int ai = 0; ai < 2; ++ai)
#pragma unroll
            for (int m = 0; m < 4; ++m) {
                const int rl = ai * HALF + wr * 64 + m * 16 + fr;
                const f32x2 p0 = X[rl * 4 + 0], p1 = X[rl * 4 + 1], p2 = X[rl * 4 + 2], p3 = X[rl * 4 + 3];
                const float M = fmaxf(fmaxf(p0.x, p1.x), fmaxf(p2.x, p3.x));
                const float L = (p0.y * __expf(p0.x - M) + p1.y * __expf(p1.x - M)) + (p2.y * __expf(p2.x - M) + p3.y * __expf(p3.x - M));
                const float inv = 1.0f / L, rs = rsv[ai][m];
                bf16_t* rowp = O + (size_t)(row0 + ai * HALF + m * 16) * D + col0;
#pragma unroll
                for (int bj = 0; bj < 2; ++bj) {
                    const f32x4 x0 = acc[ai][bj][m][0] * rs, x1 = acc[ai][bj][m][1] * rs;
                    u32x4 w;
                    w.x = cvt_pk(__expf(x0[0] - M) * inv, __expf(x0[1] - M) * inv); w.y = cvt_pk(__expf(x0[2] - M) * inv, __expf(x0[3] - M) * inv);
                    w.z = cvt_pk(__expf(x1[0] - M) * inv, __expf(x1[1] - M) * inv); w.w = cvt_pk(__expf(x1[2] - M) * inv, __expf(x1[3] - M) * inv);
                    *(u32x4*)(rowp + bj * HALF) = w;
                }
            }
    }
};
struct EpiMemKV {
    static constexpr bool PERM = false, RSTD = false;
    bf16_t* Kall; bf16_t* Vall;
    __device__ __forceinline__ void operator()(const Acc& acc, const Unit& u, int wr, int wc, int fr, int fq, const float (&pre)[2][4]) const {
        const int l = u.pn >> 3, t8 = u.pn & 7;
        bf16_t* base = Kall + (size_t)(t8 >> 2) * ((size_t)NL * MT * D) + (size_t)l * MT * D + (t8 & 3) * 256;
        const int row0 = u.pm * BM + wr * 64 + fr, cl0 = wc * 32 + 4 * fq;
#pragma unroll
        for (int ai = 0; ai < 2; ++ai)
#pragma unroll
            for (int m = 0; m < 4; ++m) {
                const int row = row0 + ai * HALF + m * 16;
#pragma unroll
                for (int bj = 0; bj < 2; ++bj)
#pragma unroll
                    for (int n = 0; n < 2; ++n) {
                        const f32x4 v = acc[ai][bj][m][n];
                        u32x2 w; w.x = cvt_pk(v[0], v[1]); w.y = cvt_pk(v[2], v[3]);
                        *(u32x2*)(base + (size_t)row * D + cl0 + bj * HALF + n * 16) = w;
                    }
            }
    }
};

template <class Epi>
__device__ __forceinline__ void gemm_phase(LAS unsigned char* lds, const Gemm g, const Sched& S, const Epi& E) {
    const int tid = opaque_tid(), wid = __builtin_amdgcn_readfirstlane(tid >> 6), lane = tid & 63, wr = wid >> 2, wc = wid & 3, fr = lane & 15, fq = lane >> 4;
    const int K = g.K, nt = K / BK;
    unsigned voffA[2], voffB[2];
#pragma unroll
    for (int i = 0; i < 2; ++i) { int R, C; stage_rc(tid * 16 + i * 8192, R, C); const int Rb = Epi::PERM ? ((R & ~31) + perm32(R & 31)) : R;
        voffA[i] = (unsigned)(R * g.lda + C) * 2u; voffB[i] = (unsigned)(Rb * g.ldb + C) * 2u; }
    const size_t kstep = (size_t)(BK * 2);
    const size_t hstepA = (size_t)HALF * g.lda * 2, hstepB = (size_t)HALF * g.ldb * 2;
    const unsigned ldsw = (unsigned)wid * 1024u;
    const int aoff = lds_byte(wr * 64 + fr, fq * 8), boff = lds_byte(wc * 32 + fr, fq * 8);
#define PG8_SA(b, h) (((b) * 2 + (h)) * HTB)
#define PG8_SB(b, h) ((4 + (b) * 2 + (h)) * HTB)
#define PG8_STAGE(bufoff, gbase, voff) do { _Pragma("unroll") for (int _i = 0; _i < 2; ++_i) \
        __builtin_amdgcn_global_load_lds((const unsigned*)((const char*)(gbase) + (voff)[_i]), (LAS unsigned*)(lds + (bufoff) + ldsw + _i * 8192), 16, 0, 0); } while (0)
#define PG8_LDA(dst, b, h) do { _Pragma("unroll") for (int m = 0; m < 4; ++m) _Pragma("unroll") for (int k = 0; k < 2; ++k) dst[m][k] = *(const LAS bf16x8*)(lds + PG8_SA(b, h) + aoff + m * 2048 + k * 1024); } while (0)
#define PG8_LDB(dst, b, h) do { _Pragma("unroll") for (int n = 0; n < 2; ++n) _Pragma("unroll") for (int k = 0; k < 2; ++k) dst[n][k] = *(const LAS bf16x8*)(lds + PG8_SB(b, h) + boff + n * 2048 + k * 1024); } while (0)
#define PG8_MMA(ai, bj, At, Bt) do { __builtin_amdgcn_s_setprio(1); _Pragma("unroll") for (int m = 0; m < 4; ++m) _Pragma("unroll") for (int n = 0; n < 2; ++n) _Pragma("unroll") for (int k = 0; k < 2; ++k) \
        acc[ai][bj][m][n] = __builtin_amdgcn_mfma_f32_16x16x32_bf16(Bt[n][k], At[m][k], acc[ai][bj][m][n], 0, 0, 0); __builtin_amdgcn_s_setprio(0); } while (0)
#define PG8_WAIT_V(n) asm volatile("s_waitcnt vmcnt(" #n ")" ::: "memory")
#define PG8_WAIT_L(n) asm volatile("s_waitcnt lgkmcnt(" #n ")" ::: "memory")
#define PG8_BAR __builtin_amdgcn_s_barrier()
#define PG8_SCHED __builtin_amdgcn_sched_barrier(0)
#define PG8_APTR(u) ((const char*)g.A + ((size_t)((u).pm >> g.aSh) * g.aHi + (size_t)((u).pm & g.aMsk) * g.aLo + (size_t)(u).pn * g.aPn) * 2)
#define PG8_BPTR(u) ((const char*)g.Bt + ((size_t)(u).pn * g.bPn + (size_t)((u).pm >> g.bSh) * g.bHi + (size_t)((u).pm & g.bMsk) * g.bLo) * 2)
    Unit cur, nxt; int ui = 0;
    if (!S.next(0, cur)) return;
    Acc acc;
#pragma unroll
    for (int a = 0; a < 2; ++a)
#pragma unroll
        for (int b = 0; b < 2; ++b)
#pragma unroll
            for (int m = 0; m < 4; ++m)
#pragma unroll
                for (int n = 0; n < 2; ++n) acc[a][b][m][n] = (f32x4){0.f, 0.f, 0.f, 0.f};
    bf16x8 At[4][2], B0[2][2], B1[2][2];
    const char* cA = PG8_APTR(cur); const char* cB = PG8_BPTR(cur);
    PG8_STAGE(PG8_SB(0, 0), cB, voffB); PG8_STAGE(PG8_SA(0, 0), cA, voffA); PG8_STAGE(PG8_SB(0, 1), cB + hstepB, voffB); PG8_STAGE(PG8_SA(0, 1), cA + hstepA, voffA);
    if (wr == 1) PG8_BAR;
    PG8_WAIT_V(4); PG8_BAR;
    PG8_STAGE(PG8_SB(1, 0), cB + kstep, voffB); PG8_STAGE(PG8_SA(1, 0), cA + kstep, voffA); PG8_STAGE(PG8_SB(1, 1), cB + hstepB + kstep, voffB);
    PG8_WAIT_V(6); PG8_BAR;
    for (;;) {
        const bool has_next = S.next(ui + 1, nxt);
        if constexpr (Epi::RSTD) {
            const float* src = E.pre_src(cur, wr, fr, fq);
            if (src) {
#pragma unroll
                for (int r8 = 0; r8 < 8; ++r8)
                    __builtin_amdgcn_global_load_lds((const unsigned*)(src + (size_t)((r8 >> 2) * HALF + (r8 & 3) * 16) * 4), (LAS unsigned*)(lds + LDS_PRE + wid * 2048 + r8 * 256), 4, 0, 0);
            }
        }
        const char* nA = has_next ? PG8_APTR(nxt) : cA; const char* nB = has_next ? PG8_BPTR(nxt) : cB;
        for (int t = 0; t < nt; t += 2) {
            const bool last = (t == nt - 2);
            const char* a1 = cA + (size_t)(t + 1) * kstep;
            const char* a2 = last ? nA : cA + (size_t)(t + 2) * kstep; const char* b2 = last ? nB : cB + (size_t)(t + 2) * kstep;
            const char* a3 = a2 + kstep; const char* b3 = b2 + kstep;
            PG8_LDB(B0, 0, 0); PG8_SCHED; PG8_LDA(At, 0, 0); PG8_STAGE(PG8_SA(1, 1), a1 + hstepA, voffA);
            PG8_WAIT_L(8); PG8_BAR; PG8_WAIT_L(0); PG8_MMA(0, 0, At, B0); PG8_BAR; PG8_SCHED;
            PG8_LDB(B1, 0, 1); PG8_STAGE(PG8_SB(0, 0), b2, voffB);
            PG8_BAR; PG8_WAIT_L(0); PG8_MMA(0, 1, At, B1); PG8_BAR;
            PG8_LDA(At, 0, 1); PG8_STAGE(PG8_SA(0, 0), a2, voffA);
            PG8_BAR; PG8_WAIT_L(0); PG8_MMA(1, 0, At, B0); PG8_BAR; PG8_SCHED;
            PG8_STAGE(PG8_SB(0, 1), b2 + hstepB, voffB);
            PG8_WAIT_V(6); PG8_BAR; PG8_MMA(1, 1, At, B1); PG8_BAR;
            PG8_LDB(B0, 1, 0); PG8_SCHED; PG8_LDA(At, 1, 0); PG8_STAGE(PG8_SA(0, 1), a2 + hstepA, voffA);
            PG8_WAIT_L(8); PG8_BAR; PG8_WAIT_L(0); PG8_MMA(0, 0, At, B0); PG8_BAR; PG8_SCHED;
            PG8_LDB(B1, 1, 1); PG8_STAGE(PG8_SB(1, 0), b3, voffB);
            PG8_BAR; PG8_WAIT_L(0); PG8_MMA(0, 1, At, B1); PG8_BAR;
            PG8_LDA(At, 1, 1); PG8_STAGE(PG8_SA(1, 0), a3, voffA);
            PG8_BAR; PG8_WAIT_L(0); PG8_MMA(1, 0, At, B0); PG8_BAR; PG8_SCHED;
            PG8_STAGE(PG8_SB(1, 1), b3 + hstepB, voffB);
            PG8_WAIT_V(6); PG8_BAR; PG8_MMA(1, 1, At, B1); PG8_BAR;
        }
        float pre[2][4];
#pragma unroll
        for (int a2 = 0; a2 < 2; ++a2)
#pragma unroll
            for (int m = 0; m < 4; ++m) pre[a2][m] = Epi::RSTD ? *(const LAS float*)(lds + LDS_PRE + wid * 2048 + (a2 * 4 + m) * 256 + lane * 4) : 0.f;
        E(acc, cur, wr, wc, fr, fq, pre);
        if (!has_next) break;
#pragma unroll
        for (int a = 0; a < 2; ++a)
#pragma unroll
            for (int b = 0; b < 2; ++b)
#pragma unroll
                for (int m = 0; m < 4; ++m)
#pragma unroll
                    for (int n = 0; n < 2; ++n) acc[a][b][m][n] = (f32x4){0.f, 0.f, 0.f, 0.f};
        cur = nxt; cA = nA; cB = nB; ++ui;
    }
    PG8_WAIT_V(0);
    if (wr == 0) PG8_BAR;
    PG8_BAR;
#undef PG8_SA
#undef PG8_SB
#undef PG8_STAGE
#undef PG8_LDA
#undef PG8_LDB
#undef PG8_MMA
#undef PG8_WAIT_V
#undef PG8_WAIT_L
#undef PG8_BAR
#undef PG8_SCHED
#undef PG8_APTR
#undef PG8_BPTR
}


#define XB_TMO      128
#define XB_XCNT(j)  (256  + 64 * (j))
#define XB_XSUB(j)  (1280 + 64 * (j))
#define XB_XGEN(j)  (2304 + 64 * (j))
#define XB_TOP      3328
#define XB_TOPGEN   3392
#define XCD_BAR_WORDS 3456
#define XB_SPIN_CAP (1u << 18)
__device__ __forceinline__ unsigned xb_ld(unsigned* p)              { return __hip_atomic_load(p, __ATOMIC_RELAXED, __HIP_MEMORY_SCOPE_AGENT); }
__device__ __forceinline__ unsigned xb_add(unsigned* p, unsigned v) { return __hip_atomic_fetch_add(p, v, __ATOMIC_RELAXED, __HIP_MEMORY_SCOPE_AGENT); }
__device__ __forceinline__ unsigned xb_xcc_id() { return (unsigned)__builtin_amdgcn_s_getreg((3 << 11) | 20) & 0xFu; }
#define XB_SPIN(cond, bar) do { unsigned _sp = 0; while (cond) { __builtin_amdgcn_s_sleep(1); \
    if ((++_sp & 255u) == 0u) { if (xb_ld(&(bar)[XB_TMO])) break; if (_sp > XB_SPIN_CAP) { atomicAdd(&(bar)[XB_TMO], 1u); break; } } } } while (0)
struct XcdBarrier { unsigned* bar; unsigned x; volatile LAS unsigned* st; };
__device__ __forceinline__ XcdBarrier xcd_barrier_post(unsigned* bar, volatile LAS unsigned* st) {
    XcdBarrier b; b.bar = bar; b.x = xb_xcc_id(); b.st = st;
    if (threadIdx.x == 0) (void)xb_add(&bar[XB_XCNT(b.x)], 1u);
    return b;
}
__device__ __forceinline__ void xcd_barrier_complete(unsigned* bar, unsigned x, unsigned& nloc, unsigned& nx) {
    const unsigned G = gridDim.x * gridDim.y * gridDim.z;
    unsigned sum, cnt, mine, sp = 0u;
    for (;;) {
        sum = 0u; cnt = 0u; mine = 0u;
#pragma unroll
        for (unsigned j = 0; j < 16; ++j) { const unsigned c = xb_ld(&bar[XB_XCNT(j)]); sum += c; cnt += (c > 0u) ? 1u : 0u; mine = (j == x) ? c : mine; }
        if (sum == G) break;
        __builtin_amdgcn_s_sleep(1);
        if ((++sp & 255u) == 0u) { if (xb_ld(&bar[XB_TMO])) break; if (sp > XB_SPIN_CAP) { atomicAdd(&bar[XB_TMO], 1u); break; } }
    }
    nloc = mine > 0u ? mine : 1u; nx = cnt > 0u ? cnt : 1u;
}
__device__ __forceinline__ void xcd_barrier(const XcdBarrier& b) {
    asm volatile("s_waitcnt vmcnt(0)" ::: "memory");
    __syncthreads();
    if (threadIdx.x == 0) {
        unsigned* bar = b.bar;
        __builtin_amdgcn_s_waitcnt(0);
        unsigned nloc = b.st[0], nx = b.st[1];
        if (nloc == 0u) { xcd_barrier_complete(bar, b.x, nloc, nx); b.st[0] = nloc; b.st[1] = nx; }
        const unsigned old = xb_add(&bar[XB_XSUB(b.x)], 1u);
        const unsigned gen = old / nloc;
        if (old + 1u == (gen + 1u) * nloc) {
            __builtin_amdgcn_fence(__ATOMIC_RELEASE, "agent");
            asm volatile("s_waitcnt vmcnt(0)" ::: "memory");
            const unsigned og = xb_add(&bar[XB_TOP], 1u);
            const unsigned tg = og / nx;
            if (og + 1u == (tg + 1u) * nx) xb_add(&bar[XB_TOPGEN], 1u);
            else XB_SPIN(xb_ld(&bar[XB_TOPGEN]) == tg, bar);
            __builtin_amdgcn_fence(__ATOMIC_ACQUIRE, "agent");
            xb_add(&bar[XB_XGEN(b.x)], 1u);
            asm volatile("s_waitcnt vmcnt(0)" ::: "memory");
        } else {
            XB_SPIN(xb_ld(&bar[XB_XGEN(b.x)]) == gen, bar);
            __builtin_amdgcn_fence(__ATOMIC_ACQUIRE, "agent");
            asm volatile("s_waitcnt vmcnt(0)" ::: "memory");
        }
    }
    __syncthreads();
}

struct Args { const float* in[32]; float* out; unsigned char* ws; int ph_lo, ph_hi; };
enum { I_X = 0, I_MEM, I_F1N, I_F1IN, I_F1OUT, I_MIXN, I_MIXIN, I_MIXOUT, I_CONVW, I_CONVB, I_LB, I_HGN, I_MU, I_W0, I_W2, I_A0, I_A2, I_G2, I_KK, I_KA, I_RK, I_LNW, I_LNB,
       I_XAN, I_MEMN, I_WQ, I_WKV, I_WO, I_F2N, I_F2IN, I_F2OUT, I_FINN };

__device__ __forceinline__ void transpose_item(const float* W, int N, int k0, int n0, const float* gain, float scale, bf16_t* WT, int ldk, int drow0, LAS float* scr, int lane) {
#pragma unroll
    for (int i = 0; i < 32; ++i) { const int kk = 2 * i + (lane >> 5); const float gk = gain ? gain[k0 + kk] * scale : scale;
        scr[kk * 33 + (lane & 31)] = W[(size_t)(k0 + kk) * N + n0 + (lane & 31)] * gk; }
    asm volatile("s_waitcnt lgkmcnt(0)" ::: "memory");
    const int c = lane & 7;
#pragma unroll
    for (int j = 0; j < 4; ++j) { const int n = (lane >> 3) + 8 * j; const LAS float* s = scr + (8 * c) * 33 + n;
        u32x4 o; o.x = pk2(s[0 * 33], s[1 * 33]); o.y = pk2(s[2 * 33], s[3 * 33]); o.z = pk2(s[4 * 33], s[5 * 33]); o.w = pk2(s[6 * 33], s[7 * 33]);
        *(u32x4*)(WT + (size_t)(drow0 + n) * ldk + k0 + 8 * c) = o; }
    asm volatile("s_waitcnt lgkmcnt(0)" ::: "memory");
}
__device__ __forceinline__ void conv_matrix_item(const float* W, int K, int N, const float* gain, float scale, bf16_t* WT, int mode, int item, LAS float* scr, int lane) {
    const int nblk = N / 32, kb = item / nblk, nb = item % nblk, k0 = 64 * kb, n0 = 32 * nb;
    int drow0 = n0;
    if (mode == 1) { const int up = n0 >= DFF, j0 = up ? n0 - DFF : n0; drow0 = 256 * (j0 / 128) + (j0 % 128) + (up ? 128 : 0); }
    transpose_item(W, N, k0, n0, gain, scale, WT, K, drow0, scr, lane);
}

__device__ __forceinline__ unsigned char* wbuf(const Args& a, int l) { return (l & 1) ? (unsigned char*)a.out + ((size_t)64 << 20) : a.ws; }
__device__ __forceinline__ void phase_convert_layer(const Args& a, LAS unsigned char* lds, int l, int first, int nblk) {
    const int tid = opaque_tid(), lane = tid & 63, wave = tid >> 6;
    LAS float* scr = (LAS float*)(lds + wave * 16384);
    const int gw = ((int)blockIdx.x - first) * 8 + wave, NGW = nblk * 8;
    unsigned char* ws = wbuf(a, l);
    constexpr int I_FIN = 16 * 176, I_FOUT = 44 * 32, I_MIN = 16 * 116, I_SQ = 16 * 32;
    constexpr int NITEMS = 2 * I_FIN + 2 * I_FOUT + I_MIN + 2 * I_SQ;
    for (int it = gw; it < NITEMS; it += NGW) {
        int r = it;
        if (r < I_FIN) { conv_matrix_item(a.in[I_F1IN] + (size_t)l * D * 2 * DFF, D, 2 * DFF, a.in[I_F1N] + l * D, 1.0f, (bf16_t*)(ws + W_FFN1_IN), 1, r, scr, lane); continue; } r -= I_FIN;
        if (r < I_FIN) { conv_matrix_item(a.in[I_F2IN] + (size_t)l * D * 2 * DFF, D, 2 * DFF, a.in[I_F2N] + l * D, 1.0f, (bf16_t*)(ws + W_FFN2_IN), 1, r, scr, lane); continue; } r -= I_FIN;
        if (r < I_FOUT) { conv_matrix_item(a.in[I_F1OUT] + (size_t)l * DFF * D, DFF, D, nullptr, 1.0f, (bf16_t*)(ws + W_FFN1_OUT), 0, r, scr, lane); continue; } r -= I_FOUT;
        if (r < I_FOUT) { conv_matrix_item(a.in[I_F2OUT] + (size_t)l * DFF * D, DFF, D, nullptr, 1.0f, (bf16_t*)(ws + W_FFN2_OUT), 0, r, scr, lane); continue; } r -= I_FOUT;
        if (r < I_MIN) { conv_matrix_item(a.in[I_MIXIN] + (size_t)l * D * INW, D, INW, a.in[I_MIXN] + l * D, 1.0f, (bf16_t*)(ws + W_MIX_IN), 0, r, scr, lane); continue; } r -= I_MIN;
        if (r < I_SQ) { conv_matrix_item(a.in[I_MIXOUT] + (size_t)l * D * D, D, D, nullptr, 1.0f, (bf16_t*)(ws + W_MIX_OUT), 0, r, scr, lane); continue; } r -= I_SQ;
        conv_matrix_item(a.in[I_WO] + (size_t)l * D * D, D, D, nullptr, 1.0f, (bf16_t*)(ws + W_O), 0, r, scr, lane);
    }
    {
        const float* wq = a.in[I_WQ] + (size_t)l * D * D; const float* gq = a.in[I_XAN] + l * D; bf16_t* wqn = (bf16_t*)(ws + W_Q);
        for (int idx = ((int)blockIdx.x - first) * 512 + tid; idx < D * D / 4; idx += nblk * 512) {
            const f32x4 v = *((const f32x4*)wq + idx) * (gq[idx >> 8] * 0.0625f);
            u32x2 w; w.x = pk2(v.x, v.y); w.y = pk2(v.z, v.w);
            *((u32x2*)wqn + idx) = w;
        }
    }
    bf16_t* lr = (bf16_t*)(ws + W_LR);
    const float* w2 = a.in[I_W2] + (size_t)l * 64 * 384; const float* a2 = a.in[I_A2] + (size_t)l * 64 * 384; const float* g2 = a.in[I_G2] + (size_t)l * 128 * 384;
    for (int idx = ((int)blockIdx.x - first) * 512 + tid; idx < LRWP * 256; idx += nblk * 512) {
        const int n = idx >> 8, k = idx & 255; float v = 0.f;
        if (n < 384) { if (k < 64) v = w2[k * 384 + n]; }
        else if (n < 768) { if (k >= 64 && k < 128) v = a2[(k - 64) * 384 + (n - 384)]; }
        else if (n < 1152) { if (k >= 128) v = g2[(k - 128) * 384 + (n - 768)]; }
        lr[idx] = (bf16_t)f2bf(v);
    }
}

__device__ __forceinline__ float lb_value(const float* lbl, int l, int c) {
    const float z0 = lbl[c], z1 = lbl[384 + c], z2 = lbl[768 + c], z3 = lbl[1152 + c];
    const float m = fmaxf(fmaxf(z0, z1), fmaxf(z2, z3));
    const float e0 = expf(z0 - m), e1 = expf(z1 - m), e2 = expf(z2 - m), e3 = expf(z3 - m);
    const float inv = 1.0f / ((e0 + e1) + (e2 + e3));
    float cs = 0.f;
    if (l >= 1) cs += e1 * inv;
    if (l >= 2) cs += e2 * inv;
    if (l >= 3) cs += e3 * inv;
    return fmaxf(cs, 0.f);
}
__device__ __forceinline__ void phase_setup(const Args& a, LAS unsigned char* lds) {
    const int tid = opaque_tid(), lane = tid & 63, wave = tid >> 6;
    const int gw = blockIdx.x * 8 + wave, NGW = gridDim.x * 8;
    unsigned char* ws = a.ws;
    bf16_t* hb = (bf16_t*)(ws + WS_HB); float* ssq = (float*)(ws + WS_SSQ);
    for (int row = gw; row < T; row += 2 * NGW) {
        const int row2 = (row + NGW < T) ? row + NGW : row;
        const f32x4* xr = (const f32x4*)(a.in[I_X] + (size_t)row * D) + lane;
        const f32x4* xr2 = (const f32x4*)(a.in[I_X] + (size_t)row2 * D) + lane;
        f32x4 v[4], v2[4];
#pragma unroll
        for (int j = 0; j < 4; ++j) { v[j] = xr[64 * j]; v2[j] = xr2[64 * j]; }
        u32x2* hbr = (u32x2*)(hb + (size_t)row * D) + lane;
        u32x2* hbr2 = (u32x2*)(hb + (size_t)row2 * D) + lane;
        float s = 0.f, s2 = 0.f;
#pragma unroll
        for (int j = 0; j < 4; ++j) {
            s += (v[j].x * v[j].x + v[j].y * v[j].y) + (v[j].z * v[j].z + v[j].w * v[j].w);
            s2 += (v2[j].x * v2[j].x + v2[j].y * v2[j].y) + (v2[j].z * v2[j].z + v2[j].w * v2[j].w);
            u32x2 w; w.x = pk2(v[j].x, v[j].y); w.y = pk2(v[j].z, v[j].w); hbr[64 * j] = w;
            u32x2 w2; w2.x = pk2(v2[j].x, v2[j].y); w2.y = pk2(v2[j].z, v2[j].w); hbr2[64 * j] = w2;
        }
        s = wave_sum(s); s2 = wave_sum(s2);
        if (lane < 4) { ssq[(size_t)row * 4 + lane] = (lane == 0) ? s : 0.f; ssq[(size_t)row2 * 4 + lane] = (lane == 0) ? s2 : 0.f; }
    }
    bf16_t* memh = (bf16_t*)(ws + WS_S1 + S1_MEMH);
    for (int row = gw; row < MT; row += NGW) {
        const f32x4* xr = (const f32x4*)(a.in[I_MEM] + (size_t)row * D) + lane;
        u32x2* o = (u32x2*)(memh + (size_t)row * D) + lane;
        f32x4 v[4]; float s = 0.f;
#pragma unroll
        for (int j = 0; j < 4; ++j) { v[j] = xr[64 * j]; s += (v[j].x * v[j].x + v[j].y * v[j].y) + (v[j].z * v[j].z + v[j].w * v[j].w); }
        const float rs = rsqrtf(wave_sum(s) * (1.0f / 1024.0f) + EPS);
#pragma unroll
        for (int j = 0; j < 4; ++j) { u32x2 w; w.x = pk2(v[j].x * rs, v[j].y * rs); w.y = pk2(v[j].z * rs, v[j].w * rs); o[64 * j] = w; }
    }
    if (blockIdx.x == 0) for (int i = tid; i < NL * 384; i += 512) ((float*)(ws + WS_LB))[i] = lb_value(a.in[I_LB], i / 384, i % 384);
    phase_convert_layer(a, lds, 0, 0, (int)gridDim.x);
    LAS float* scr = (LAS float*)(lds + wave * 16384);
    bf16_t* wkvT = (bf16_t*)(ws + WS_S1 + S1_WKV);
    constexpr int I_KV = 16 * 64;
    for (int it = gw; it < NL * I_KV; it += NGW) {
        const int l = it / I_KV, r = it % I_KV;
        conv_matrix_item(a.in[I_WKV] + (size_t)l * D * 2048, D, 2048, a.in[I_MEMN] + l * D, 1.0f, wkvT + (size_t)l * 2048 * D, 0, r, scr, lane);
    }
}

__device__ __forceinline__ void phase_prep(const Args& a, int l) {
    const int tid = opaque_tid(), lane = tid & 63, wave = tid >> 6;
    const int gw = blockIdx.x * 8 + wave, NGW = gridDim.x * 8;
    const bf16_t* p = (const bf16_t*)(a.ws + WS_S1); bf16_t* lrin = (bf16_t*)(a.ws + WS_LRIN);
    const f32x4 mu = *(const f32x4*)(a.in[I_MU] + (size_t)l * 1408 + 1152 + 4 * lane);
    for (int tk = gw; tk < T; tk += NGW) {
        const bf16_t* src = p + (size_t)tk * INW + PC_RW + 1152 + 4 * lane;
        const u32x2 c = *(const u32x2*)src;
        u32x2 pv = (u32x2){0u, 0u};
        if ((tk & (SEQ - 1)) != 0) pv = *(const u32x2*)(src - INW);
        float x[4] = {bflo(c.x), bfhi(c.x), bflo(c.y), bfhi(c.y)};
        const float xp[4] = {bflo(pv.x), bfhi(pv.x), bflo(pv.y), bfhi(pv.y)};
#pragma unroll
        for (int j = 0; j < 4; ++j) { x[j] = x[j] + (xp[j] - x[j]) * mu[j];
            if (lane < 16) x[j] = tanh_f(x[j]); else if (lane >= 32) x[j] = sigm(x[j]); }
        u32x2 w; w.x = pk2(x[0], x[1]); w.y = pk2(x[2], x[3]);
        *(u32x2*)(lrin + (size_t)tk * 256 + 4 * lane) = w;
    }
}

constexpr int CH = 32;
#define LDS_BARRIER() do { asm volatile("s_waitcnt lgkmcnt(0)" ::: "memory"); __builtin_amdgcn_s_barrier(); asm volatile("" ::: "memory"); } while (0)
__device__ __forceinline__ void scan_unit(const Args& a, LAS unsigned char* lds, int l, int b, int h, int qt) {
    const int tid = opaque_tid(), tok = tid >> 4, q = tid & 15, rl = (tid & 255) >> 4;
    const bool is_rw = __builtin_amdgcn_readfirstlane(tid >> 8) == 0;
    LAS float* L = (LAS float*)lds;
    LAS float* RA = L; LAS float* RB = L + 2048; LAS float* RW = L + 4096; LAS float* RK = L + 6144; LAS float* RR = L + 8192; LAS float* RV = L + 10240;
    LAS float* HQ = L + 10752; LAS float* HF = L + 12800; LAS float* HK = L + 14848; LAS float* HV = L + 16896;
    LAS float* YR = L + 17408; LAS float* YH = L + 17920;
    const bf16_t* p = (const bf16_t*)(a.ws + WS_S1); const bf16_t* lr = (const bf16_t*)(a.ws + WS_LROUT); bf16_t* yraw = (bf16_t*)a.out;
    const float* mu = a.in[I_MU] + (size_t)l * 1408;
    const int c4 = h * 64 + 4 * q, cv = h * 64 + qt * 16 + q;
    const f32x4 mu_r = *(const f32x4*)(mu + c4), mu_k = *(const f32x4*)(mu + 384 + c4);
    const float mu_v = mu[768 + cv];
    const f32x4 kkp = *(const f32x4*)(a.in[I_KK] + l * 384 + c4), kap = *(const f32x4*)(a.in[I_KA] + l * 384 + c4);
    f32x2 S01 = (f32x2){0.f, 0.f}, S23 = (f32x2){0.f, 0.f};
    const bool up4 = __builtin_amdgcn_update_dpp(0, q, 0x124, 0xF, 0xF, true) == (q ^ 4);
    const size_t tb = (size_t)b * SEQ;
    u32x2 r_c, r_p, k_c, k_p, lw_c, a_c, q_c, z_c; bf16_t v_c, v_p, hv_c;
#define SC_LOAD(t0) do { const size_t tg = tb + (t0) + tok; const bf16_t* pr = p + tg * INW; \
        r_c = *(const u32x2*)(pr + PC_RW + c4); k_c = *(const u32x2*)(pr + PC_RW + 384 + c4); v_c = pr[PC_RW + 768 + cv]; \
        if ((t0) + tok != 0) { r_p = *(const u32x2*)(pr - INW + PC_RW + c4); k_p = *(const u32x2*)(pr - INW + PC_RW + 384 + c4); v_p = pr[PC_RW + 768 + cv - INW]; } \
        else { r_p = (u32x2){0u, 0u}; k_p = (u32x2){0u, 0u}; v_p = 0; } \
        lw_c = *(const u32x2*)(lr + tg * LRW + c4); a_c = *(const u32x2*)(lr + tg * LRW + 384 + c4); \
        q_c = *(const u32x2*)(pr + PC_HG + c4); z_c = *(const u32x2*)(pr + PC_HG + 384 + c4); hv_c = pr[PC_HG + 768 + cv]; } while (0)
    SC_LOAD(0);
    for (int c = 0; c < SEQ / CH; ++c) {
        {
            const float rc[4] = {bflo(r_c.x), bfhi(r_c.x), bflo(r_c.y), bfhi(r_c.y)}, rp[4] = {bflo(r_p.x), bfhi(r_p.x), bflo(r_p.y), bfhi(r_p.y)};
            const float kc[4] = {bflo(k_c.x), bfhi(k_c.x), bflo(k_c.y), bfhi(k_c.y)}, kp[4] = {bflo(k_p.x), bfhi(k_p.x), bflo(k_p.y), bfhi(k_p.y)};
            const float lw[4] = {bflo(lw_c.x), bfhi(lw_c.x), bflo(lw_c.y), bfhi(lw_c.y)}, av[4] = {bflo(a_c.x), bfhi(a_c.x), bflo(a_c.y), bfhi(a_c.y)};
            f32x4 rs, ks, kk, A, B, W, Kq;
            float n2 = 0.f;
#pragma unroll
            for (int j = 0; j < 4; ++j) { rs[j] = rc[j] + (rp[j] - rc[j]) * mu_r[j]; ks[j] = kc[j] + (kp[j] - kc[j]) * mu_k[j]; kk[j] = ks[j] * kkp[j]; n2 += kk[j] * kk[j]; }
            n2 = sum16(n2);
            const float inv = rsqrtf(fmaxf(n2, 1e-24f));
#pragma unroll
            for (int j = 0; j < 4; ++j) { const float kn = kk[j] * inv; A[j] = -kn; B[j] = kn * av[j]; W[j] = __expf(lw[j]); Kq[j] = ks[j] * (1.0f + (av[j] - 1.0f) * kap[j]); }
            *(LAS f32x4*)(RA + tok * 64 + 4 * q) = A; *(LAS f32x4*)(RB + tok * 64 + 4 * q) = B; *(LAS f32x4*)(RW + tok * 64 + 4 * q) = W;
            *(LAS f32x4*)(RK + tok * 64 + 4 * q) = Kq; *(LAS f32x4*)(RR + tok * 64 + 4 * q) = rs;
            const float v0 = __uint_as_float((unsigned)v_c << 16), vp0 = __uint_as_float((unsigned)v_p << 16);
            RV[tok * 16 + q] = v0 + (vp0 - v0) * mu_v;
        }
        {
            const f32x4 Q = (f32x4){bflo(q_c.x), bfhi(q_c.x), bflo(q_c.y), bfhi(q_c.y)}, Kx = (f32x4){bflo(z_c.x), bfhi(z_c.x), bflo(z_c.y), bfhi(z_c.y)};
            *(LAS f32x4*)(HQ + tok * 64 + 4 * q) = Q; *(LAS f32x4*)(HK + tok * 64 + 4 * q) = Kx;
            HV[tok * 16 + q] = __uint_as_float((unsigned)hv_c << 16);
        }
        LDS_BARRIER();
        if (c + 1 < SEQ / CH) SC_LOAD((c + 1) * CH);
        if (is_rw) {
            f32x4 A = *(const LAS f32x4*)(RA + 4 * q), B = *(const LAS f32x4*)(RB + 4 * q), W = *(const LAS f32x4*)(RW + 4 * q);
            f32x4 Kq = *(const LAS f32x4*)(RK + 4 * q), R = *(const LAS f32x4*)(RR + 4 * q);
            float v = RV[rl];
#pragma unroll 1
            for (int t0 = 0; t0 < CH; t0 += 16) {
                float yp[16];
#pragma unroll
                for (int i = 0; i < 16; ++i) {
                    const int tn = (t0 + i + 1) * 64 + 4 * q;
                    const f32x4 nA = *(const LAS f32x4*)(RA + tn), nB = *(const LAS f32x4*)(RB + tn), nW = *(const LAS f32x4*)(RW + tn);
                    const f32x4 nK = *(const LAS f32x4*)(RK + tn), nR = *(const LAS f32x4*)(RR + tn);
                    const float nv = RV[(t0 + i + 1) * 16 + rl];
                    __builtin_amdgcn_sched_barrier(0);
                    f32x2 d = S01 * A.xy; d = S23 * A.zw + d;
                    const float sa = sum16(d.x + d.y);
                    const f32x2 vv = (f32x2){v, v}, sv = (f32x2){sa, sa};
                    const f32x2 t01 = S01 * W.xy + vv * Kq.xy, t23 = S23 * W.zw + vv * Kq.zw;
                    S01 = sv * B.xy + t01; S23 = sv * B.zw + t23;
                    f32x2 e = S01 * R.xy; e = S23 * R.zw + e;
                    yp[i] = e.x + e.y;
                    A = nA; B = nB; W = nW; Kq = nK; R = nR; v = nv;
                }
                YR[(t0 + q) * 16 + rl] = reduce_scatter16(yp, q, up4);
            }
        } else {
            f32x4 Q = *(const LAS f32x4*)(HQ + 4 * q), Kx = *(const LAS f32x4*)(HK + 4 * q);
            float v = HV[rl];
#pragma unroll 1
            for (int t0 = 0; t0 < CH; t0 += 16) {
                float op[16];
#pragma unroll
                for (int i = 0; i < 16; ++i) {
                    const int tn = (t0 + i + 1) * 64 + 4 * q;
                    const f32x4 nQ = *(const LAS f32x4*)(HQ + tn), nK = *(const LAS f32x4*)(HK + tn);
                    const float nv = HV[(t0 + i + 1) * 16 + rl];
                    __builtin_amdgcn_sched_barrier(0);
                    const f32x2 vv = (f32x2){v, v};
                    S01 = Kx.xy * (vv - S01) + S01; S23 = Kx.zw * (vv - S23) + S23;
                    f32x2 e = S01 * Q.xy; e = S23 * Q.zw + e;
                    op[i] = e.x + e.y;
                    Q = nQ; Kx = nK; v = nv;
                }
                YH[(t0 + q) * 16 + rl] = reduce_scatter16(op, q, up4);
            }
        }
        LDS_BARRIER();
        {
            const int tk2 = (tid & 255) >> 3, pr2 = tid & 7;
            const f32x2 yy = *(const LAS f32x2*)((is_rw ? YR : YH) + tk2 * 16 + 2 * pr2);
            *(unsigned*)(yraw + (tb + (size_t)c * CH + tk2) * 768 + (is_rw ? 384 : 0) + h * 64 + qt * 16 + 2 * pr2) = pk2(yy.x, yy.y);
        }
    }
#undef SC_LOAD
    LDS_BARRIER();
}
__device__ __forceinline__ void phase_scan(const Args& a, LAS unsigned char* lds, int l) {
    for (int s = blockIdx.x; s < 192; s += gridDim.x) scan_unit(a, lds, l, s / 24, (s % 24) >> 2, s & 3);
    if (l + 1 < NL) {
        const int first = gridDim.x > 192 ? 192 : 0;
        if ((int)blockIdx.x >= first) phase_convert_layer(a, lds, l + 1, first, (int)gridDim.x - first);
    }
}

__device__ __forceinline__ f32x4 ld4bf(const bf16_t* p) { const u32x2 w = *(const u32x2*)p; return (f32x4){bflo(w.x), bfhi(w.x), bflo(w.y), bfhi(w.y)}; }
__device__ __forceinline__ void st4bf(bf16_t* p, f32x4 v) { u32x2 w; w.x = pk2(v.x, v.y); w.y = pk2(v.z, v.w); *(u32x2*)p = w; }
__device__ __forceinline__ f32x4 cvt4bf(u32x2 w) { return (f32x4){bflo(w.x), bfhi(w.x), bflo(w.y), bfhi(w.y)}; }
__device__ __forceinline__ void phase_post(const Args& a, int l) {
    const int tid = opaque_tid(), q = tid & 15, wave = __builtin_amdgcn_readfirstlane(tid >> 6), sub4 = (tid >> 4) & 3;
    const bf16_t* p = (const bf16_t*)(a.ws + WS_S1); const bf16_t* lr = (const bf16_t*)(a.ws + WS_LROUT); const bf16_t* yraw = (const bf16_t*)a.out;
    bf16_t* y = (bf16_t*)(a.ws + WS_YQ);
    const int it0 = blockIdx.x, nit = T / 2, dit = gridDim.x;
    const u32x2 Z = (u32x2){0u, 0u};
    if (wave < 2) {
        const int i = wave * 4 + sub4, sub = i >> 2, c = (i & 3) * 64 + 4 * q;
        const float* cw = a.in[I_CONVW] + (size_t)l * 768;
        const f32x4 w0 = *(const f32x4*)(cw + c), w1 = *(const f32x4*)(cw + 256 + c), w2 = *(const f32x4*)(cw + 512 + c), cb = *(const f32x4*)(a.in[I_CONVB] + l * 256 + c);
        u32x2 bg, c0, x0, c1, x1, c2, x2;
#define CV_LOAD(it) do { const int tk = 2 * (it) + sub, t = tk & (SEQ - 1); const bf16_t* pr = p + (size_t)tk * INW + c; \
            bg = *(const u32x2*)pr; c0 = *(const u32x2*)(pr + 256); x0 = *(const u32x2*)(pr + 512); \
            if (t >= 1) { c1 = *(const u32x2*)(pr - INW + 256); x1 = *(const u32x2*)(pr - INW + 512); } else { c1 = Z; x1 = Z; } \
            if (t >= 2) { c2 = *(const u32x2*)(pr - 2 * INW + 256); x2 = *(const u32x2*)(pr - 2 * INW + 512); } else { c2 = Z; x2 = Z; } } while (0)
        CV_LOAD(it0);
        for (int it = it0; it < nit; it += dit) {
            const f32x4 fb = cvt4bf(bg), z0 = cvt4bf(c0) * cvt4bf(x0), z1 = cvt4bf(c1) * cvt4bf(x1), z2 = cvt4bf(c2) * cvt4bf(x2);
            if (it + dit < nit) CV_LOAD(it + dit);
            st4bf(y + (size_t)(2 * it + sub) * D + c, fb * ((w0 * z2 + w1 * z1 + w2 * z0) + cb));
        }
#undef CV_LOAD
    } else if (wave < 5) {
        const int i = (wave - 2) * 4 + sub4, sub = i >= 6 ? 1 : 0, c = (i - 6 * sub) * 64 + 4 * q;
        const f32x4 hn = *(const f32x4*)(a.in[I_HGN] + l * 384 + c);
        u32x2 ro, rg;
#define HG_LOAD(it) do { const int tk = 2 * (it) + sub; ro = *(const u32x2*)(yraw + (size_t)tk * 768 + c); rg = *(const u32x2*)(p + (size_t)tk * INW + PC_HG + 1152 + c); } while (0)
        HG_LOAD(it0);
        for (int it = it0; it < nit; it += dit) {
            const f32x4 o = cvt4bf(ro), g = cvt4bf(rg);
            if (it + dit < nit) HG_LOAD(it + dit);
            const float ms = sum16((o.x * o.x + o.y * o.y) + (o.z * o.z + o.w * o.w)) * (1.0f / 64.0f);
            const float rs = rsqrtf(ms + EPS);
            st4bf(y + (size_t)(2 * it + sub) * D + 256 + c, o * rs * hn * g);
        }
#undef HG_LOAD
    } else {
        const int i = (wave - 5) * 4 + sub4, sub = i >= 6 ? 1 : 0, c = (i - 6 * sub) * 64 + 4 * q;
        const float* mu = a.in[I_MU] + (size_t)l * 1408;
        const f32x4 mur = *(const f32x4*)(mu + c), muk = *(const f32x4*)(mu + 384 + c), muv = *(const f32x4*)(mu + 768 + c);
        const f32x4 ka = *(const f32x4*)(a.in[I_KA] + l * 384 + c), rk = *(const f32x4*)(a.in[I_RK] + l * 384 + c);
        const f32x4 lnw = *(const f32x4*)(a.in[I_LNW] + l * 384 + c), lnb = *(const f32x4*)(a.in[I_LNB] + l * 384 + c);
        u32x2 ry, rr, rrp, rkk, rkp, rv, rvp, ra, rg;
#define RW_LOAD(it) do { const int tk = 2 * (it) + sub, t = tk & (SEQ - 1); const bf16_t* pr = p + (size_t)tk * INW + PC_RW + c; \
            ry = *(const u32x2*)(yraw + (size_t)tk * 768 + 384 + c); rr = *(const u32x2*)pr; rkk = *(const u32x2*)(pr + 384); rv = *(const u32x2*)(pr + 768); \
            if (t >= 1) { rrp = *(const u32x2*)(pr - INW); rkp = *(const u32x2*)(pr - INW + 384); rvp = *(const u32x2*)(pr - INW + 768); } else { rrp = Z; rkp = Z; rvp = Z; } \
            ra = *(const u32x2*)(lr + (size_t)tk * LRW + 384 + c); rg = *(const u32x2*)(lr + (size_t)tk * LRW + 768 + c); } while (0)
        RW_LOAD(it0);
        for (int it = it0; it < nit; it += dit) {
            const f32x4 yv = cvt4bf(ry), av = cvt4bf(ra), g = cvt4bf(rg);
            f32x4 r = cvt4bf(rr), k = cvt4bf(rkk), v = cvt4bf(rv);
            r = r + (cvt4bf(rrp) - r) * mur; k = k + (cvt4bf(rkp) - k) * muk; v = v + (cvt4bf(rvp) - v) * muv;
            if (it + dit < nit) RW_LOAD(it + dit);
            float s1 = (yv.x + yv.y) + (yv.z + yv.w), bs = 0.f;
#pragma unroll
            for (int jj = 0; jj < 4; ++jj) bs += r[jj] * (k[jj] * (1.0f + (av[jj] - 1.0f) * ka[jj])) * rk[jj];
            sum16x2(s1, bs);
            const f32x4 d = yv - s1 * (1.0f / 64.0f);
            const float var = sum16((d.x * d.x + d.y * d.y) + (d.z * d.z + d.w * d.w)) * (1.0f / 64.0f);
            const float rs = rsqrtf(var + 64e-5f);
            st4bf(y + (size_t)(2 * it + sub) * D + 640 + c, ((d * rs * lnw + lnb) + v * bs) * g);
        }
#undef RW_LOAD
    }
}

__device__ __forceinline__ void phase_final(const Args& a) {
    const int tid = opaque_tid(), lane = tid & 63, wave = tid >> 6;
    const int gw = blockIdx.x * 8 + wave, NGW = gridDim.x * 8;
    const bf16_t* hb = (const bf16_t*)(a.ws + WS_HB);
    const f32x4* gn = (const f32x4*)(a.in[I_FINN]) + lane;
    const f32x4 g0 = gn[0], g1 = gn[64], g2 = gn[128], g3 = gn[192];
    for (int row = gw; row < T; row += 2 * NGW) {
        const int row2 = (row + NGW < T) ? row + NGW : row;
        const u32x2* hr = (const u32x2*)(hb + (size_t)row * D) + lane;
        const u32x2* hr2 = (const u32x2*)(hb + (size_t)row2 * D) + lane;
        u32x2 w[4], w2[4];
#pragma unroll
        for (int j = 0; j < 4; ++j) { w[j] = hr[64 * j]; w2[j] = hr2[64 * j]; }
        f32x4 v[4], v2[4]; float s = 0.f, s2 = 0.f;
#pragma unroll
        for (int j = 0; j < 4; ++j) {
            v[j] = (f32x4){bflo(w[j].x), bfhi(w[j].x), bflo(w[j].y), bfhi(w[j].y)}; v2[j] = (f32x4){bflo(w2[j].x), bfhi(w2[j].x), bflo(w2[j].y), bfhi(w2[j].y)};
            s += (v[j].x * v[j].x + v[j].y * v[j].y) + (v[j].z * v[j].z + v[j].w * v[j].w);
            s2 += (v2[j].x * v2[j].x + v2[j].y * v2[j].y) + (v2[j].z * v2[j].z + v2[j].w * v2[j].w);
        }
        const float rs = rsqrtf(wave_sum(s) * (1.0f / 1024.0f) + EPS), rs2 = rsqrtf(wave_sum(s2) * (1.0f / 1024.0f) + EPS);
        f32x4* orow = (f32x4*)(a.out + (size_t)row * D) + lane;
        f32x4* orow2 = (f32x4*)(a.out + (size_t)row2 * D) + lane;
        orow[0] = v[0] * rs * g0; orow[64] = v[1] * rs * g1; orow[128] = v[2] * rs * g2; orow[192] = v[3] * rs * g3;
        orow2[0] = v2[0] * rs2 * g0; orow2[64] = v2[1] * rs2 * g1; orow2[128] = v2[2] * rs2 * g2; orow2[192] = v2[3] * rs2 * g3;
    }
}

#ifdef DIS_MISC
#define MISC(x) do {} while (0)
#else
#define MISC(x) x
#endif
enum { K_NONE = 0, K_BF16, K_SWIGLU, K_RESID, K_LOWRANK, K_SOFTMAX, K_MEMKV };
__global__ void __launch_bounds__(512) mk_fwd(Args a) {
    extern __shared__ __attribute__((aligned(16))) unsigned char lds_raw[];
    LAS unsigned char* lds = (LAS unsigned char*)lds_raw;
    cg::grid_group grid = cg::this_grid();
    unsigned char* ws = a.ws;
    float* ssq = (float*)(ws + WS_SSQ);
    bf16_t* hb = (bf16_t*)(ws + WS_HB);
    if (threadIdx.x < 2) ((volatile LAS unsigned*)(lds + LDS_MISC))[threadIdx.x] = 0u;
    __syncthreads();
    const XcdBarrier xbar = xcd_barrier_post((unsigned*)(ws + WS_CTL), (volatile LAS unsigned*)(lds + LDS_MISC));
    for (int ph = a.ph_lo; ph < a.ph_hi; ++ph) {
      const int kk = (ph >= 2 && ph < NPH - 1) ? (ph - 2) % 12 : -1;
      const int nrep = (kk == 5) ? 2 : ((DUP_K >= 0 && kk == DUP_K) ? 2 : 1);
      for (int rep = 0; rep < nrep; ++rep) {
        int kind = K_NONE;
        Gemm g; g.A = nullptr; g.Bt = nullptr; g.M = T; g.N = D; g.K = D; g.lda = D; g.ldb = D;
        g.aHi = 0xffffffffu; g.aLo = 0; g.aPn = 0; g.bPn = 0xffffffffu; g.bHi = 0; g.bLo = 0; g.aSh = 0; g.aMsk = 0; g.bSh = 0; g.bMsk = 0;
        bf16_t* o1 = nullptr; int ldc = D, ncols = D, emode = 0; const float* rs_ssq = nullptr; float alpha = 1.0f;
        int l = 0, sG = (int)gridDim.x, sC = (int)blockIdx.x;
#ifdef DIS_MISC
        if (ph == 0) { }
#else
        if (ph == 0) { phase_setup(a, lds); }
#endif
        else if (ph == 1) {
            kind = K_MEMKV; g.A = (const bf16_t*)(ws + WS_S1 + S1_MEMH); g.Bt = (const bf16_t*)(ws + WS_S1 + S1_WKV); g.M = MT; g.N = 8192;
#ifdef DIS_MISC
        } else if (ph == NPH - 1) { }
#else
        } else if (ph == NPH - 1) { phase_final(a); }
#endif
        else {
            l = (ph - 2) / 12; const int k = kk;
            const unsigned char* wb = wbuf(a, l);
            bf16_t* Mt = (bf16_t*)(ws + WS_LRIN);
            bf16_t* PWt = (bf16_t*)((unsigned char*)a.out + ((size_t)112 << 20));
            switch (k) {
            case 0: case 10: kind = K_SWIGLU; g.A = hb; g.Bt = (const bf16_t*)(wb + (k == 0 ? W_FFN1_IN : W_FFN2_IN)); g.N = 2 * DFF; o1 = (bf16_t*)(ws + WS_S1); break;
            case 1: case 11: kind = K_RESID; g.A = (const bf16_t*)(ws + WS_S1); g.Bt = (const bf16_t*)(wb + (k == 1 ? W_FFN1_OUT : W_FFN2_OUT)); g.K = DFF; g.lda = DFF; g.ldb = DFF; alpha = 0.5f; break;
            case 2: kind = K_BF16; g.A = hb; g.Bt = (const bf16_t*)(wb + W_MIX_IN); g.N = INWP; o1 = (bf16_t*)(ws + WS_S1); ldc = INW; ncols = INW; rs_ssq = ssq; emode = 1; break;
            case 3: MISC(phase_prep(a, l)); break;
            case 4: kind = K_LOWRANK; g.A = (const bf16_t*)(ws + WS_LRIN); g.Bt = (const bf16_t*)(wb + W_LR); g.N = LRWP; g.K = 256; g.lda = 256; g.ldb = 256; break;
            case 5: {
                if (rep == 0) { MISC(phase_scan(a, lds, l)); __syncthreads(); }
                const int first = gridDim.x > 192 ? 192 : 0;
                if ((int)blockIdx.x >= first) {
                    kind = K_BF16; sG = (int)gridDim.x - first; sC = (int)blockIdx.x - first;
                    g.M = 8192; g.N = D; g.K = 256;
                    if (rep == 0) { g.A = (const bf16_t*)(ws + WS_KALL) + (size_t)l * MT * D; g.Bt = (const bf16_t*)(wb + W_Q); o1 = Mt;
                                    g.aSh = 2; g.aHi = 256u * D; g.aMsk = 3; g.aLo = 256; g.bPn = 256u * D; g.bMsk = 3; g.bLo = 256; }
                    else          { g.A = (const bf16_t*)(wb + W_O); g.Bt = (const bf16_t*)(ws + WS_VT) + (size_t)l * MT * D; o1 = PWt;
                                    g.aHi = 0; g.aMsk = 3; g.aLo = 256u * D; g.aPn = 256; g.bPn = 256; g.bSh = 2; g.bHi = 256u * D; }
                }
            } break;
            case 6: MISC(phase_post(a, l)); break;
            case 7: kind = K_RESID; g.A = (const bf16_t*)(ws + WS_YQ); g.Bt = (const bf16_t*)(wb + W_MIX_OUT); break;
            case 8: kind = K_SOFTMAX; g.A = hb; g.Bt = Mt; g.bPn = 256u * D; g.bSh = 4; g.bHi = 4u * 256 * D; break;
            case 9: kind = K_RESID; g.A = (const bf16_t*)(ws + WS_S1); g.Bt = PWt; g.bPn = 256u * D; g.bSh = 4; g.bHi = (unsigned)(D * D); break;
            }
        }
        if (g.aHi == 0xffffffffu) g.aHi = (unsigned)(BM * g.lda);
        if (g.bPn == 0xffffffffu) g.bPn = (unsigned)(BM * g.ldb);
        if (kind != K_NONE) {
            Sched S; S.init(g.M, g.N, sG, sC);
            switch (kind) {
#ifndef DIS_K_BF16
            case K_BF16: { EpiBf16S E; E.O = o1; E.ldc = ldc; E.ncols = ncols; E.ssq = rs_ssq; E.mode = emode; E.lb = (const float*)(ws + WS_LB) + l * 384; gemm_phase(lds, g, S, E); } break;
#endif
#ifndef DIS_K_SWIGLU
            case K_SWIGLU: { EpiSwiglu E; E.O = o1; E.ssq = ssq; gemm_phase(lds, g, S, E); } break;
#endif
#ifndef DIS_K_RESID
            case K_RESID: { EpiResid E; E.hb = hb; E.ssq = ssq; E.lds = lds; E.alpha = (rep == 0) ? alpha : 0.0f; gemm_phase(lds, g, S, E); } break;
#endif
#ifndef DIS_K_LOWRANK
            case K_LOWRANK: { EpiLowrank E; E.O = (bf16_t*)(ws + WS_LROUT); E.w0 = a.in[I_W0] + l * 384; E.a0 = a.in[I_A0] + l * 384; gemm_phase(lds, g, S, E); } break;
#endif
#ifndef DIS_K_SOFTMAX
            case K_SOFTMAX: { EpiSoftmax E; E.O = (bf16_t*)(ws + WS_S1); E.lds = lds; E.ssq = ssq; gemm_phase(lds, g, S, E); } break;
#endif
#ifndef DIS_K_MEMKV
            case K_MEMKV: { EpiMemKV E; E.Kall = (bf16_t*)(ws + WS_KALL); E.Vall = (bf16_t*)(ws + WS_VT); gemm_phase(lds, g, S, E); } break;
#endif
            }
        }
      }
        if (ph + 1 < a.ph_hi) { if (ph == a.ph_lo) grid.sync(); else xcd_barrier(xbar); if (DUP_SYNC) xcd_barrier(xbar); }
    }
}

extern "C" void kernel_launch(void* const* d_in, const int* in_sizes, int n_in, void* d_out, int out_size, void* d_ws, size_t ws_size, hipStream_t stream) {
    static int grid = 0;
    if (grid == 0) {
        if (n_in != 32 || out_size != T * D || ws_size < WS_END) { fprintf(stderr, "kernel_launch: unexpected shapes (n_in %d out %d ws %zu need %zu)\n", n_in, out_size, ws_size, (size_t)WS_END); grid = -1; return; }
        int dev = 0, cus = 0, per_cu = 0;
        hipGetDevice(&dev);
        hipDeviceGetAttribute(&cus, hipDeviceAttributeMultiprocessorCount, dev);
        hipFuncSetAttribute((const void*)mk_fwd, hipFuncAttributeMaxDynamicSharedMemorySize, LDS_BYTES);
        hipOccupancyMaxActiveBlocksPerMultiprocessor(&per_cu, (const void*)mk_fwd, 512, LDS_BYTES);
        if (per_cu < 1) per_cu = 1;
        grid = cus * per_cu;
        (void)hipGetLastError();
    }
    if (grid < 0) return;
    if (hipMemsetAsync((char*)d_ws + WS_CTL, 0, CTL_BYTES, stream) != hipSuccess) { fprintf(stderr, "kernel_launch: memset failed\n"); return; }
    Args a{};
    for (int i = 0; i < 32; ++i) a.in[i] = (const float*)d_in[i];
    a.out = (float*)d_out; a.ws = (unsigned char*)d_ws;
#if MK_PER_PHASE_LAUNCH
    for (int ph = 0; ph < NPH; ++ph) {
        a.ph_lo = ph; a.ph_hi = ph + 1;
        void* args[] = {&a};
        hipError_t e = hipLaunchCooperativeKernel((const void*)mk_fwd, dim3(grid), dim3(512), args, LDS_BYTES, stream);
        if (e != hipSuccess) { fprintf(stderr, "launch of phase %d failed: %s\n", ph, hipGetErrorString(e)); break; }
    }
#else
    a.ph_lo = 0; a.ph_hi = NPH;
    void* args[] = {&a};
    hipError_t e = hipLaunchCooperativeKernel((const void*)mk_fwd, dim3(grid), dim3(512), args, LDS_BYTES, stream);
    if (e != hipSuccess) fprintf(stderr, "cooperative launch failed: %s (grid %d)\n", hipGetErrorString(e), grid);
#endif
}
```

```cpp
#include <hip/hip_runtime.h>
#include <hip/hip_cooperative_groups.h>
#include <cstdio>
namespace cg = cooperative_groups;

#ifndef MK_PER_PHASE_LAUNCH
#define MK_PER_PHASE_LAUNCH 0
#endif

#ifndef DUP_K
#define DUP_K -1
#endif
#ifndef DUP_SYNC
#define DUP_SYNC 0
#endif
#define LAS __attribute__((address_space(3)))
typedef unsigned short bf16_t;
typedef short bf16x8 __attribute__((ext_vector_type(8)));
typedef float f32x4 __attribute__((ext_vector_type(4)));
typedef float f32x2 __attribute__((ext_vector_type(2)));
typedef unsigned u32x4 __attribute__((ext_vector_type(4)));
typedef unsigned u32x2 __attribute__((ext_vector_type(2)));

constexpr int T = 32768, D = 1024, SEQ = 4096, DFF = 2816, NL = 4;
constexpr int MT = 2048;
constexpr int INW = 3712, INWP = 3840;
constexpr int PC_HG = 768, PC_RW = 2304;
constexpr int LRW = 1152, LRWP = 1280;
constexpr float EPS = 1e-6f;

constexpr size_t W_FFN1_IN = 0;
constexpr size_t W_FFN1_OUT = W_FFN1_IN + (size_t)5632 * 1024 * 2;
constexpr size_t W_MIX_IN = W_FFN1_OUT + (size_t)1024 * 2816 * 2;
constexpr size_t W_LR = W_MIX_IN + (size_t)INWP * 1024 * 2;
constexpr size_t W_MIX_OUT = W_LR + (size_t)LRWP * 256 * 2;
constexpr size_t W_Q = W_MIX_OUT + (size_t)1024 * 1024 * 2;
constexpr size_t W_O = W_Q + (size_t)1024 * 1024 * 2;
constexpr size_t W_FFN2_IN = W_O + (size_t)1024 * 1024 * 2;
constexpr size_t W_FFN2_OUT = W_FFN2_IN + (size_t)5632 * 1024 * 2;
constexpr size_t W_END = W_FFN2_OUT + (size_t)1024 * 2816 * 2;
constexpr size_t WS_HB = W_END;
constexpr size_t WS_S1 = WS_HB + (size_t)T * 1024 * 2;
constexpr size_t S1_BYTES = (size_t)T * INW * 2;
constexpr size_t WS_LRIN = WS_S1 + S1_BYTES;
constexpr size_t WS_LROUT = WS_LRIN + (size_t)T * 256 * 2;
constexpr size_t WS_YQ = WS_LROUT + (size_t)T * LRW * 2;
constexpr size_t WS_KALL = WS_YQ + (size_t)T * 1024 * 2;
constexpr size_t WS_VT = WS_KALL + (size_t)NL * MT * 1024 * 2;
constexpr size_t WS_SSQ = WS_VT + (size_t)NL * MT * 1024 * 2;
constexpr size_t WS_CTL = WS_SSQ + (size_t)T * 16 * 4;
constexpr size_t CTL_BYTES = 16384;
constexpr size_t WS_LB = WS_CTL + CTL_BYTES;
constexpr size_t WS_END = WS_LB + 8192;
constexpr size_t S1_O = (size_t)T * 1024 * 2;
constexpr size_t S1_WKV = 0, S1_MEMH = (size_t)8192 * 1024 * 2;

constexpr int LDS_STAGE = 131072, LDS_XCH = 131072, LDS_MISC = 131072 + 8192, LDS_PRE = 131072 + 8192 + 256, LDS_BYTES = LDS_PRE + 16384;
constexpr int NPH = 2 + 12 * NL + 1;

__device__ __forceinline__ int opaque_tid() { int t = threadIdx.x; asm volatile("" : "+v"(t)); return t; }
__device__ __forceinline__ unsigned f2bf(float f) { unsigned u = __float_as_uint(f); return (u + 0x7fffu + ((u >> 16) & 1u)) >> 16; }
__device__ __forceinline__ unsigned pk2(float lo, float hi) { return f2bf(lo) | (f2bf(hi) << 16); }
__device__ __forceinline__ unsigned cvt_pk(float lo, float hi) { unsigned r; asm volatile("v_cvt_pk_bf16_f32 %0, %1, %2" : "=v"(r) : "v"(lo), "v"(hi)); return r; }
__device__ __forceinline__ float bflo(unsigned w) { return __uint_as_float(w << 16); }
__device__ __forceinline__ float bfhi(unsigned w) { return __uint_as_float(w & 0xffff0000u); }
__device__ __forceinline__ float bf1(const bf16_t* p) { return __uint_as_float(((unsigned)*p) << 16); }
__device__ __forceinline__ float sigm(float x) { return __builtin_amdgcn_rcpf(1.0f + __expf(-x)); }
__device__ __forceinline__ float silu(float x) { return x * sigm(x); }
__device__ __forceinline__ float tanh_f(float x) { return 1.0f - 2.0f * __builtin_amdgcn_rcpf(__expf(2.0f * x) + 1.0f); }
__device__ __forceinline__ float wave_sum(float v) {
#pragma unroll
    for (int o = 1; o < 64; o <<= 1) v += __shfl_xor(v, o);
    return v;
}
template <int CTRL> __device__ __forceinline__ float dppf(float v) { return __int_as_float(__builtin_amdgcn_update_dpp(0, __float_as_int(v), CTRL, 0xF, 0xF, true)); }
__device__ __forceinline__ float sum16(float x) {
    x += dppf<0xB1>(x);
    x += dppf<0x4E>(x);
    x += dppf<0x124>(x);
    x += dppf<0x128>(x);
    return x;
}
__device__ __forceinline__ void sum16x2(float& a, float& b) {
    a += dppf<0xB1>(a); b += dppf<0xB1>(b); a += dppf<0x4E>(a); b += dppf<0x4E>(b);
    a += dppf<0x124>(a); b += dppf<0x124>(b); a += dppf<0x128>(a); b += dppf<0x128>(b);
}
__device__ __forceinline__ float reduce_scatter16(const float (&p)[16], int q, bool up4) {
    const bool b0 = (q & 1) != 0, b1 = (q & 2) != 0, b2 = (q & 4) != 0, b3 = (q & 8) != 0;
    float r[8], u[4], w[2];
#pragma unroll
    for (int i = 0; i < 8; ++i) { const float keep = b0 ? p[2 * i + 1] : p[2 * i], send = b0 ? p[2 * i] : p[2 * i + 1]; r[i] = keep + dppf<0xB1>(send); }
#pragma unroll
    for (int i = 0; i < 4; ++i) { const float keep = b1 ? r[2 * i + 1] : r[2 * i], send = b1 ? r[2 * i] : r[2 * i + 1]; u[i] = keep + dppf<0x4E>(send); }
#pragma unroll
    for (int i = 0; i < 2; ++i) { const float keep = b3 ? u[2 + i] : u[i], send = b3 ? u[i] : u[2 + i]; w[i] = keep + dppf<0x128>(send); }
    const float keep = b2 ? w[1] : w[0], send = b2 ? w[0] : w[1];
    const float r4 = dppf<0x124>(send), r12 = dppf<0x12C>(send);
    return keep + (up4 ? r4 : r12);
}
__device__ __forceinline__ void rstd8_load(const float* ssq, int row0, int fq, float (&pre)[2][4]) {
#pragma unroll
    for (int ai = 0; ai < 2; ++ai)
#pragma unroll
        for (int m = 0; m < 4; ++m) pre[ai][m] = ssq[(size_t)(row0 + ai * 128 + m * 16) * 4 + fq];
}
__device__ __forceinline__ void rstd8_finish(const float (&pre)[2][4], float (&rsv)[2][4]) {
#pragma unroll
    for (int ai = 0; ai < 2; ++ai)
#pragma unroll
        for (int m = 0; m < 4; ++m) {
            float sm = pre[ai][m];
            sm += __shfl_xor(sm, 16); sm += __shfl_xor(sm, 32);
            rsv[ai][m] = rsqrtf(sm * (1.0f / 1024.0f) + EPS);
        }
}

constexpr int BM = 256, BK = 64, HALF = 128, HTB = HALF * BK * 2, NXCD = 8, WGM = 8;
__device__ __forceinline__ int lds_byte(int r, int c) { const int st = (r >> 4) * 2 + (c >> 5), rr = r & 15, cc = c & 31, ob = rr * 64 + cc * 2; return st * 1024 + (ob ^ (((ob >> 9) & 1) << 5)); }
__device__ __forceinline__ void stage_rc(int b, int& R, int& C) { const int st = b / 1024, sb = b % 1024, swz = sb ^ (((sb >> 9) & 1) << 5); R = (st >> 1) * 16 + swz / 64; C = (st & 1) * 32 + (swz % 64) / 2; }
__device__ __forceinline__ int perm32(int rho) { const int n = rho >> 4, i = rho & 15; return 8 * (i >> 2) + 4 * n + (i & 3); }

struct Unit { int pm, pn; };
struct Gemm { const bf16_t* A; const bf16_t* Bt; int M, N, K, lda, ldb; unsigned aHi, aLo, aPn, bPn, bHi, bLo; int aSh, aMsk, bSh, bMsk; };
struct Sched {
    int nM, nN, nwg, G, c;
    __device__ __forceinline__ void init(int M, int N, int G_, int c_) { nM = M / BM; nN = N / BM; nwg = nM * nN; G = G_; c = c_; }
    __device__ __forceinline__ bool next(int i, Unit& u) const {
        const long L = (long)i * G + c; if (L >= nwg) return false;
        int wgid = (int)L; { const int q = nwg / NXCD, r = nwg % NXCD, xcd = wgid % NXCD, off = wgid / NXCD; wgid = (xcd < r ? xcd * (q + 1) : r * (q + 1) + (xcd - r) * q) + off; }
        const int nig = WGM * nN, gid = wgid / nig, fm = gid * WGM, gsz = (nM - fm) < WGM ? (nM - fm) : WGM;
        u.pm = fm + ((wgid % nig) % gsz); u.pn = (wgid % nig) / gsz; return true;
    }
};

typedef f32x4 Acc[2][2][4][2];

struct EpiBf16S {
    static constexpr bool PERM = true, RSTD = true;
    bf16_t* O; int ldc, ncols; const float* ssq; int mode; const float* lb;
    __device__ __forceinline__ const float* pre_src(const Unit& u, int wr, int fr, int fq) const { return ssq ? ssq + (size_t)(u.pm * BM + wr * 64 + fr) * 4 + fq : nullptr; }
    __device__ __forceinline__ void operator()(const Acc& acc, const Unit& u, int wr, int wc, int fr, int fq, const float (&pre)[2][4]) const {
        const int row0 = u.pm * BM + wr * 64 + fr, col0 = u.pn * BM + wc * 32 + 8 * fq;
        float rsv[2][4];
        if (ssq) rstd8_finish(pre, rsv);
        else {
#pragma unroll
            for (int ai = 0; ai < 2; ++ai)
#pragma unroll
                for (int m = 0; m < 4; ++m) rsv[ai][m] = 1.0f;
        }
#pragma unroll
        for (int bj = 0; bj < 2; ++bj) {
            const int cb = u.pn * BM + bj * HALF;
            if (cb >= ncols) continue;
            int type = 0;
            f32x4 l0 = (f32x4){0.f, 0.f, 0.f, 0.f}, l1 = l0;
            if (mode == 1) {
                if ((cb >= 768 && cb < 1152) || (cb >= 1920 && cb < 2304)) type = 1;
                else if (cb >= 1152 && cb < 1536) { type = 2; l0 = *(const f32x4*)(lb + col0 + bj * HALF - 1152); l1 = *(const f32x4*)(lb + col0 + bj * HALF - 1152 + 4); }
            }
#pragma unroll
            for (int ai = 0; ai < 2; ++ai)
#pragma unroll
                for (int m = 0; m < 4; ++m) {
                    const int row = row0 + ai * HALF + m * 16;
                    const float rs = rsv[ai][m];
                    f32x4 v0 = acc[ai][bj][m][0] * rs, v1 = acc[ai][bj][m][1] * rs;
                    if (type == 1) {
#pragma unroll
                        for (int j = 0; j < 4; ++j) { v0[j] = silu(v0[j]); v1[j] = silu(v1[j]); }
                    } else if (type == 2) {
#pragma unroll
                        for (int j = 0; j < 4; ++j) { v0[j] = (1.0f - l0[j]) * sigm(-v0[j]); v1[j] = (1.0f - l1[j]) * sigm(-v1[j]); }
                    }
                    u32x4 w; w.x = cvt_pk(v0[0], v0[1]); w.y = cvt_pk(v0[2], v0[3]); w.z = cvt_pk(v1[0], v1[1]); w.w = cvt_pk(v1[2], v1[3]);
                    *(u32x4*)(O + (size_t)row * ldc + col0 + bj * HALF) = w;
                }
        }
    }
};
struct EpiSwiglu {
    static constexpr bool PERM = true, RSTD = true;
    bf16_t* O; const float* ssq;
    __device__ __forceinline__ const float* pre_src(const Unit& u, int wr, int fr, int fq) const { return ssq ? ssq + (size_t)(u.pm * BM + wr * 64 + fr) * 4 + fq : nullptr; }
    __device__ __forceinline__ void operator()(const Acc& acc, const Unit& u, int wr, int wc, int fr, int fq, const float (&pre)[2][4]) const {
        const int row0 = u.pm * BM + wr * 64 + fr, col0 = u.pn * HALF + wc * 32 + 8 * fq;
        float rsv[2][4];
        rstd8_finish(pre, rsv);
#pragma unroll
        for (int ai = 0; ai < 2; ++ai)
#pragma unroll
            for (int m = 0; m < 4; ++m) {
                const int row = row0 + ai * HALF + m * 16;
                const float rs = rsv[ai][m];
                float o[8];
#pragma unroll
                for (int n = 0; n < 2; ++n)
#pragma unroll
                    for (int j = 0; j < 4; ++j) { const float g = acc[ai][0][m][n][j] * rs, up = acc[ai][1][m][n][j] * rs; o[n * 4 + j] = silu(g) * up; }
                u32x4 w; w.x = cvt_pk(o[0], o[1]); w.y = cvt_pk(o[2], o[3]); w.z = cvt_pk(o[4], o[5]); w.w = cvt_pk(o[6], o[7]);
                *(u32x4*)(O + (size_t)row * DFF + col0) = w;
            }
    }
};
struct EpiResid {
    static constexpr bool PERM = true, RSTD = false;
    bf16_t* hb; float* ssq; float alpha; LAS unsigned char* lds;
    __device__ __forceinline__ void operator()(const Acc& acc, const Unit& u, int wr, int wc, int fr, int fq, const float (&pre)[2][4]) const {
        const int row0 = u.pm * BM + wr * 64 + fr, col0 = u.pn * BM + wc * 32 + 8 * fq;
        u32x4 h0w[4][2], h1w[4][2]; float ss0[4], ss1[4];
        LAS float* X = (LAS float*)(lds + LDS_XCH);
#pragma unroll
        for (int m = 0; m < 4; ++m)
#pragma unroll
            for (int bj = 0; bj < 2; ++bj) h0w[m][bj] = *(const u32x4*)(hb + (size_t)(row0 + m * 16) * D + col0 + bj * HALF);
#define RESID_COMPUTE(HW, SS, AI) _Pragma("unroll") for (int m = 0; m < 4; ++m) { float ss = 0.f; _Pragma("unroll") for (int bj = 0; bj < 2; ++bj) { const u32x4 w0 = HW[m][bj]; \
            f32x4 a0 = (f32x4){bflo(w0.x), bfhi(w0.x), bflo(w0.y), bfhi(w0.y)}, a1 = (f32x4){bflo(w0.z), bfhi(w0.z), bflo(w0.w), bfhi(w0.w)}; \
            a0 = a0 + acc[AI][bj][m][0] * alpha; a1 = a1 + acc[AI][bj][m][1] * alpha; \
            ss += ((a0[0] * a0[0] + a0[1] * a0[1]) + (a0[2] * a0[2] + a0[3] * a0[3])) + ((a1[0] * a1[0] + a1[1] * a1[1]) + (a1[2] * a1[2] + a1[3] * a1[3])); \
            u32x4 w; w.x = cvt_pk(a0[0], a0[1]); w.y = cvt_pk(a0[2], a0[3]); w.z = cvt_pk(a1[0], a1[1]); w.w = cvt_pk(a1[2], a1[3]); HW[m][bj] = w; } SS[m] = ss; }
#define RESID_STORE(HW, SS, AI) _Pragma("unroll") for (int m = 0; m < 4; ++m) { const int row = row0 + AI * HALF + m * 16; \
            _Pragma("unroll") for (int bj = 0; bj < 2; ++bj) *(u32x4*)(hb + (size_t)row * D + col0 + bj * HALF) = HW[m][bj]; \
            float ss = SS[m]; ss += __shfl_xor(ss, 16); ss += __shfl_xor(ss, 32); if (fq == 0) X[(AI * HALF + wr * 64 + m * 16 + fr) * 4 + wc] = ss; }
        RESID_COMPUTE(h0w, ss0, 0)
        asm volatile("" ::: "memory");
#pragma unroll
        for (int m = 0; m < 4; ++m)
#pragma unroll
            for (int bj = 0; bj < 2; ++bj) h1w[m][bj] = *(const u32x4*)(hb + (size_t)(row0 + HALF + m * 16) * D + col0 + bj * HALF);
        asm volatile("" ::: "memory");
        RESID_STORE(h0w, ss0, 0)
        RESID_COMPUTE(h1w, ss1, 1)
        RESID_STORE(h1w, ss1, 1)
#undef RESID_COMPUTE
#undef RESID_STORE
        asm volatile("s_waitcnt lgkmcnt(0)" ::: "memory"); __builtin_amdgcn_s_barrier(); asm volatile("" ::: "memory");
        if (fq == 0) {
#pragma unroll
            for (int ai = 0; ai < 2; ++ai) {
                const int rl = ai * HALF + wr * 64 + wc * 16 + fr;
                const f32x4 x = *(const LAS f32x4*)(X + rl * 4);
                ssq[(size_t)(u.pm * BM + rl) * 4 + u.pn] = (x.x + x.y) + (x.z + x.w);
            }
        }
    }
};
struct EpiLowrank {
    static constexpr bool PERM = true, RSTD = false;
    bf16_t* O; const float* w0; const float* a0;
    __device__ __forceinline__ void operator()(const Acc& acc, const Unit& u, int wr, int wc, int fr, int fq, const float (&pre)[2][4]) const {
        const int row0 = u.pm * BM + wr * 64 + fr;
#pragma unroll
        for (int bj = 0; bj < 2; ++bj) {
            const int cb = u.pn * BM + bj * HALF;
            if (cb >= LRW) continue;
            const int type = cb / 384, col0 = cb + wc * 32 + 8 * fq;
            f32x4 b0 = (f32x4){0.f, 0.f, 0.f, 0.f}, b1 = b0;
            if (type == 0) { b0 = *(const f32x4*)(w0 + col0); b1 = *(const f32x4*)(w0 + col0 + 4); }
            if (type == 1) { b0 = *(const f32x4*)(a0 + col0 - 384); b1 = *(const f32x4*)(a0 + col0 - 384 + 4); }
#pragma unroll
            for (int ai = 0; ai < 2; ++ai)
#pragma unroll
                for (int m = 0; m < 4; ++m) {
                    const int row = row0 + ai * HALF + m * 16;
                    f32x4 v0 = acc[ai][bj][m][0] + b0, v1 = acc[ai][bj][m][1] + b1;
                    if (type == 0) {
#pragma unroll
                        for (int j = 0; j < 4; ++j) { v0[j] = -0.606531f * sigm(v0[j]); v1[j] = -0.606531f * sigm(v1[j]); }
                    } else if (type == 1) {
#pragma unroll
                        for (int j = 0; j < 4; ++j) { v0[j] = sigm(v0[j]); v1[j] = sigm(v1[j]); }
                    }
                    u32x4 w; w.x = cvt_pk(v0[0], v0[1]); w.y = cvt_pk(v0[2], v0[3]); w.z = cvt_pk(v1[0], v1[1]); w.w = cvt_pk(v1[2], v1[3]);
                    *(u32x4*)(O + (size_t)row * LRW + col0) = w;
                }
        }
    }
};
struct EpiSoftmax {
    static constexpr bool PERM = true, RSTD = true;
    bf16_t* O; LAS unsigned char* lds; const float* ssq;
    __device__ __forceinline__ const float* pre_src(const Unit& u, int wr, int fr, int fq) const { return ssq ? ssq + (size_t)(u.pm * BM + wr * 64 + fr) * 4 + fq : nullptr; }
    __device__ __forceinline__ void operator()(const Acc& acc, const Unit& u, int wr, int wc, int fr, int fq, const float (&pre)[2][4]) const {
        LAS f32x2* X = (LAS f32x2*)(lds + LDS_XCH);
        const int row0 = u.pm * BM + wr * 64 + fr, col0 = u.pn * BM + wc * 32 + 8 * fq;
        float rsv[2][4];
        rstd8_finish(pre, rsv);
#pragma unroll
        for (int ai = 0; ai < 2; ++ai)
#pragma unroll
            for (int m = 0; m < 4; ++m) {
                const float rs = rsv[ai][m];
                float mx = -3.0e38f;
#pragma unroll
                for (int bj = 0; bj < 2; ++bj)
#pragma unroll
                    for (int n = 0; n < 2; ++n) { const f32x4 x = acc[ai][bj][m][n] * rs; mx = fmaxf(mx, fmaxf(fmaxf(x[0], x[1]), fmaxf(x[2], x[3]))); }
                mx = fmaxf(mx, __shfl_xor(mx, 16)); mx = fmaxf(mx, __shfl_xor(mx, 32));
                float l = 0.f;
#pragma unroll
                for (int bj = 0; bj < 2; ++bj)
#pragma unroll
                    for (int n = 0; n < 2; ++n) { const f32x4 x = acc[ai][bj][m][n] * rs; l += (__expf(x[0] - mx) + __expf(x[1] - mx)) + (__expf(x[2] - mx) + __expf(x[3] - mx)); }
                l += __shfl_xor(l, 16); l += __shfl_xor(l, 32);
                if (fq == 0) X[(ai * HALF + wr * 64 + m * 16 + fr) * 4 + wc] = (f32x2){mx, l};
            }
        asm volatile("s_waitcnt lgkmcnt(0)" ::: "memory"); __builtin_amdgcn_s_barrier(); asm volatile("" ::: "memory");
#pragma unroll
        for (int ai = 0; ai < 2; ++ai)
#pragma unroll
            for (int m = 0; m < 4; ++m) {
                const int rl = ai * HALF + wr * 64 + m * 16 + fr;
                const f32x2 p0 = X[rl * 4 + 0], p1 = X[rl * 4 + 1], p2 = X[rl * 4 + 2], p3 = X[rl * 4 + 3];
                const float M = fmaxf(fmaxf(p0.x, p1.x), fmaxf(p2.x, p3.x));
                const float L = (p0.y * __expf(p0.x - M) + p1.y * __expf(p1.x - M)) + (p2.y * __expf(p2.x - M) + p3.y * __expf(p3.x - M));
                const float inv = 1.0f / L, rs = rsv[ai][m];
                bf16_t* rowp = O + (size_t)(row0 + ai * HALF + m * 16) * D + col0;
#pragma unroll
                for (int bj = 0; bj < 2; ++bj) {
                    const f32x4 x0 = acc[ai][bj][m][0] * rs, x1 = acc[ai][bj][m][1] * rs;
                    u32x4 w;
                    w.x = cvt_pk(__expf(x0[0] - M) * inv, __expf(x0[1] - M) * inv); w.y = cvt_pk(__expf(x0[2] - M) * inv, __expf(x0[3] - M) * inv);
                    w.z = cvt_pk(__expf(x1[0] - M) * inv, __expf(x1[1] - M) * inv); w.w = cvt_pk(__expf(x1[2] - M) * inv, __expf(x1[3] - M) * inv);
                    *(u32x4*)(rowp + bj * HALF) = w;
                }
            }
    }
};
struct EpiMemKV {
    static constexpr bool PERM = false, RSTD = false;
    bf16_t* Kall; bf16_t* Vall;
    __device__ __forceinline__ void operator()(const Acc& acc, const Unit& u, int wr, int wc, int fr, int fq, const float (&pre)[2][4]) const {
        const int l = u.pn >> 3, t8 = u.pn & 7;
        bf16_t* base = Kall + (size_t)(t8 >> 2) * ((size_t)NL * MT * D) + (size_t)l * MT * D + (t8 & 3) * 256;
        const int row0 = u.pm * BM + wr * 64 + fr, cl0 = wc * 32 + 4 * fq;
#pragma unroll
        for (int ai = 0; ai < 2; ++ai)
#pragma unroll
            for (int m = 0; m < 4; ++m) {
                const int row = row0 + ai * HALF + m * 16;
#pragma unroll
                for (int bj = 0; bj < 2; ++bj)
#pragma unroll
                    for (int n = 0; n < 2; ++n) {
                        const f32x4 v = acc[ai][bj][m][n];
                        u32x2 w; w.x = cvt_pk(v[0], v[1]); w.y = cvt_pk(v[2], v[3]);
                        *(u32x2*)(base + (size_t)row * D + cl0 + bj * HALF + n * 16) = w;
                    }
            }
    }
};

template <class Epi>
__device__ __forceinline__ void gemm_phase(LAS unsigned char* lds, const Gemm g, const Sched& S, const Epi& E) {
    const int tid = opaque_tid(), wid = __builtin_amdgcn_readfirstlane(tid >> 6), lane = tid & 63, wr = wid >> 2, wc = wid & 3, fr = lane & 15, fq = lane >> 4;
    const int K = g.K, nt = K / BK;
    unsigned voffA[2], voffB[2];
#pragma unroll
    for (int i = 0; i < 2; ++i) { int R, C; stage_rc(tid * 16 + i * 8192, R, C); const int Rb = Epi::PERM ? ((R & ~31) + perm32(R & 31)) : R;
        voffA[i] = (unsigned)(R * g.lda + C) * 2u; voffB[i] = (unsigned)(Rb * g.ldb + C) * 2u; }
    const size_t kstep = (size_t)(BK * 2);
    const size_t hstepA = (size_t)HALF * g.lda * 2, hstepB = (size_t)HALF * g.ldb * 2;
    const unsigned ldsw = (unsigned)wid * 1024u;
    const int aoff = lds_byte(wr * 64 + fr, fq * 8), boff = lds_byte(wc * 32 + fr, fq * 8);
#define PG8_SA(b, h) (((b) * 2 + (h)) * HTB)
#define PG8_SB(b, h) ((4 + (b) * 2 + (h)) * HTB)
#define PG8_STAGE(bufoff, gbase, voff) do { _Pragma("unroll") for (int _i = 0; _i < 2; ++_i) \
        __builtin_amdgcn_global_load_lds((const unsigned*)((const char*)(gbase) + (voff)[_i]), (LAS unsigned*)(lds + (bufoff) + ldsw + _i * 8192), 16, 0, 0); } while (0)
#define PG8_LDA(dst, b, h) do { _Pragma("unroll") for (int m = 0; m < 4; ++m) _Pragma("unroll") for (int k = 0; k < 2; ++k) dst[m][k] = *(const LAS bf16x8*)(lds + PG8_SA(b, h) + aoff + m * 2048 + k * 1024); } while (0)
#define PG8_LDB(dst, b, h) do { _Pragma("unroll") for (int n = 0; n < 2; ++n) _Pragma("unroll") for (int k = 0; k < 2; ++k) dst[n][k] = *(const LAS bf16x8*)(lds + PG8_SB(b, h) + boff + n * 2048 + k * 1024); } while (0)
#define PG8_MMA(ai, bj, At, Bt) do { __builtin_amdgcn_s_setprio(1); _Pragma("unroll") for (int m = 0; m < 4; ++m) _Pragma("unroll") for (int n = 0; n < 2; ++n) _Pragma("unroll") for (int k = 0; k < 2; ++k) \
        acc[ai][bj][m][n] = __builtin_amdgcn_mfma_f32_16x16x32_bf16(Bt[n][k], At[m][k], acc[ai][bj][m][n], 0, 0, 0); __builtin_amdgcn_s_setprio(0); } while (0)
#define PG8_WAIT_V(n) asm volatile("s_waitcnt vmcnt(" #n ")" ::: "memory")
#define PG8_WAIT_L(n) asm volatile("s_waitcnt lgkmcnt(" #n ")" ::: "memory")
#define PG8_BAR __builtin_amdgcn_s_barrier()
#define PG8_SCHED __builtin_amdgcn_sched_barrier(0)
#define PG8_APTR(u) ((const char*)g.A + ((size_t)((u).pm >> g.aSh) * g.aHi + (size_t)((u).pm & g.aMsk) * g.aLo + (size_t)(u).pn * g.aPn) * 2)
#define PG8_BPTR(u) ((const char*)g.Bt + ((size_t)(u).pn * g.bPn + (size_t)((u).pm >> g.bSh) * g.bHi + (size_t)((u).pm & g.bMsk) * g.bLo) * 2)
    Unit cur, nxt; int ui = 0;
    if (!S.next(0, cur)) return;
    Acc acc;
#pragma unroll
    for (int a = 0; a < 2; ++a)
#pragma unroll
        for (int b = 0; b < 2; ++b)
#pragma unroll
            for (int m = 0; m < 4; ++m)
#pragma unroll
                for (int n = 0; n < 2; ++n) acc[a][b][m][n] = (f32x4){0.f, 0.f, 0.f, 0.f};
    bf16x8 At[4][2], B0[2][2], B1[2][2];
    const char* cA = PG8_APTR(cur); const char* cB = PG8_BPTR(cur);
    PG8_STAGE(PG8_SB(0, 0), cB, voffB); PG8_STAGE(PG8_SA(0, 0), cA, voffA); PG8_STAGE(PG8_SB(0, 1), cB + hstepB, voffB); PG8_STAGE(PG8_SA(0, 1), cA + hstepA, voffA);
    if (wr == 1) PG8_BAR;
    PG8_WAIT_V(4); PG8_BAR;
    PG8_STAGE(PG8_SB(1, 0), cB + kstep, voffB); PG8_STAGE(PG8_SA(1, 0), cA + kstep, voffA); PG8_STAGE(PG8_SB(1, 1), cB + hstepB + kstep, voffB);
    PG8_WAIT_V(6); PG8_BAR;
    for (;;) {
        const bool has_next = S.next(ui + 1, nxt);
        if constexpr (Epi::RSTD) {
            const float* src = E.pre_src(cur, wr, fr, fq);
            if (src) {
#pragma unroll
                for (int r8 = 0; r8 < 8; ++r8)
                    __builtin_amdgcn_global_load_lds((const unsigned*)(src + (size_t)((r8 >> 2) * HALF + (r8 & 3) * 16) * 4), (LAS unsigned*)(lds + LDS_PRE + wid * 2048 + r8 * 256), 4, 0, 0);
            }
        }
        const char* nA = has_next ? PG8_APTR(nxt) : cA; const char* nB = has_next ? PG8_BPTR(nxt) : cB;
        for (int t = 0; t < nt; t += 2) {
            const bool last = (t == nt - 2);
            const char* a1 = cA + (size_t)(t + 1) * kstep;
            const char* a2 = last ? nA : cA + (size_t)(t + 2) * kstep; const char* b2 = last ? nB : cB + (size_t)(t + 2) * kstep;
            const char* a3 = a2 + kstep; const char* b3 = b2 + kstep;
            PG8_LDB(B0, 0, 0); PG8_SCHED; PG8_LDA(At, 0, 0); PG8_STAGE(PG8_SA(1, 1), a1 + hstepA, voffA);
            PG8_WAIT_L(8); PG8_BAR; PG8_WAIT_L(0); PG8_MMA(0, 0, At, B0); PG8_BAR; PG8_SCHED;
            PG8_LDB(B1, 0, 1); PG8_STAGE(PG8_SB(0, 0), b2, voffB);
            PG8_BAR; PG8_WAIT_L(0); PG8_MMA(0, 1, At, B1); PG8_BAR;
            PG8_LDA(At, 0, 1); PG8_STAGE(PG8_SA(0, 0), a2, voffA);
            PG8_BAR; PG8_WAIT_L(0); PG8_MMA(1, 0, At, B0); PG8_BAR; PG8_SCHED;
            PG8_STAGE(PG8_SB(0, 1), b2 + hstepB, voffB);
            PG8_WAIT_V(6); PG8_BAR; PG8_MMA(1, 1, At, B1); PG8_BAR;
            PG8_LDB(B0, 1, 0); PG8_SCHED; PG8_LDA(At, 1, 0); PG8_STAGE(PG8_SA(0, 1), a2 + hstepA, voffA);
            PG8_WAIT_L(8); PG8_BAR; PG8_WAIT_L(0); PG8_MMA(0, 0, At, B0); PG8_BAR; PG8_SCHED;
            PG8_LDB(B1, 1, 1); PG8_STAGE(PG8_SB(1, 0), b3, voffB);
            PG8_BAR; PG8_WAIT_L(0); PG8_MMA(0, 1, At, B1); PG8_BAR;
            PG8_LDA(At, 1, 1); PG8_STAGE(PG8_SA(1, 0), a3, voffA);
            PG8_BAR; PG8_WAIT_L(0); PG8_MMA(1, 0, At, B0); PG8_BAR; PG8_SCHED;
            PG8_STAGE(PG8_SB(1, 1), b3 + hstepB, voffB);
            PG8_WAIT_V(6); PG8_BAR; PG8_MMA(1, 1, At, B1); PG8_BAR;
        }
        float pre[2][4];
#pragma unroll
        for (int a2 = 0; a2 < 2; ++a2)
#pragma unroll
            for (int m = 0; m < 4; ++m) pre[a2][m] = Epi::RSTD ? *(const LAS float*)(lds + LDS_PRE + wid * 2048 + (a2 * 4 + m) * 256 + lane * 4) : 0.f;
        E(acc, cur, wr, wc, fr, fq, pre);
        if (!has_next) break;
#pragma unroll
        for (int a = 0; a < 2; ++a)
#pragma unroll
            for (int b = 0; b < 2; ++b)
#pragma unroll
                for (int m = 0; m < 4; ++m)
#pragma unroll
                    for (int n = 0; n < 2; ++n) acc[a][b][m][n] = (f32x4){0.f, 0.f, 0.f, 0.f};
        cur = nxt; cA = nA; cB = nB; ++ui;
    }
    PG8_WAIT_V(0);
    if (wr == 0) PG8_BAR;
    PG8_BAR;
#undef PG8_SA
#undef PG8_SB
#undef PG8_STAGE
#undef PG8_LDA
#undef PG8_LDB
#undef PG8_MMA
#undef PG8_WAIT_V
#undef PG8_WAIT_L
#undef PG8_BAR
#undef PG8_SCHED
#undef PG8_APTR
#undef PG8_BPTR
}


#define XB_TMO      128
#define XB_XCNT(j)  (256  + 64 * (j))
#define XB_XSUB(j)  (1280 + 64 * (j))
#define XB_XGEN(j)  (2304 + 64 * (j))
#define XB_TOP      3328
#define XB_TOPGEN   3392
#define XCD_BAR_WORDS 3456
#define XB_SPIN_CAP (1u << 18)
__device__ __forceinline__ unsigned xb_ld(unsigned* p)              { return __hip_atomic_load(p, __ATOMIC_RELAXED, __HIP_MEMORY_SCOPE_AGENT); }
__device__ __forceinline__ unsigned xb_add(unsigned* p, unsigned v) { return __hip_atomic_fetch_add(p, v, __ATOMIC_RELAXED, __HIP_MEMORY_SCOPE_AGENT); }
__device__ __forceinline__ unsigned xb_xcc_id() { return (unsigned)__builtin_amdgcn_s_getreg((3 << 11) | 20) & 0xFu; }
#define XB_SPIN(cond, bar) do { unsigned _sp = 0; while (cond) { __builtin_amdgcn_s_sleep(1); \
    if ((++_sp & 255u) == 0u) { if (xb_ld(&(bar)[XB_TMO])) break; if (_sp > XB_SPIN_CAP) { atomicAdd(&(bar)[XB_TMO], 1u); break; } } } } while (0)
struct XcdBarrier { unsigned* bar; unsigned x; volatile LAS unsigned* st; };
__device__ __forceinline__ XcdBarrier xcd_barrier_post(unsigned* bar, volatile LAS unsigned* st) {
    XcdBarrier b; b.bar = bar; b.x = xb_xcc_id(); b.st = st;
    if (threadIdx.x == 0) (void)xb_add(&bar[XB_XCNT(b.x)], 1u);
    return b;
}
__device__ __forceinline__ void xcd_barrier_complete(unsigned* bar, unsigned x, unsigned& nloc, unsigned& nx) {
    const unsigned G = gridDim.x * gridDim.y * gridDim.z;
    unsigned sum, cnt, mine, sp = 0u;
    for (;;) {
        sum = 0u; cnt = 0u; mine = 0u;
#pragma unroll
        for (unsigned j = 0; j < 16; ++j) { const unsigned c = xb_ld(&bar[XB_XCNT(j)]); sum += c; cnt += (c > 0u) ? 1u : 0u; mine = (j == x) ? c : mine; }
        if (sum == G) break;
        __builtin_amdgcn_s_sleep(1);
        if ((++sp & 255u) == 0u) { if (xb_ld(&bar[XB_TMO])) break; if (sp > XB_SPIN_CAP) { atomicAdd(&bar[XB_TMO], 1u); break; } }
    }
    nloc = mine > 0u ? mine : 1u; nx = cnt > 0u ? cnt : 1u;
}
__device__ __forceinline__ void xcd_barrier(const XcdBarrier& b) {
    asm volatile("s_waitcnt vmcnt(0)" ::: "memory");
    __syncthreads();
    if (threadIdx.x == 0) {
        unsigned* bar = b.bar;
        __builtin_amdgcn_s_waitcnt(0);
        unsigned nloc = b.st[0], nx = b.st[1];
        if (nloc == 0u) { xcd_barrier_complete(bar, b.x, nloc, nx); b.st[0] = nloc; b.st[1] = nx; }
        const unsigned old = xb_add(&bar[XB_XSUB(b.x)], 1u);
        const unsigned gen = old / nloc;
        if (old + 1u == (gen + 1u) * nloc) {
            __builtin_amdgcn_fence(__ATOMIC_RELEASE, "agent");
            asm volatile("s_waitcnt vmcnt(0)" ::: "memory");
            const unsigned og = xb_add(&bar[XB_TOP], 1u);
            const unsigned tg = og / nx;
            if (og + 1u == (tg + 1u) * nx) xb_add(&bar[XB_TOPGEN], 1u);
            else XB_SPIN(xb_ld(&bar[XB_TOPGEN]) == tg, bar);
            __builtin_amdgcn_fence(__ATOMIC_ACQUIRE, "agent");
            xb_add(&bar[XB_XGEN(b.x)], 1u);
            asm volatile("s_waitcnt vmcnt(0)" ::: "memory");
        } else {
            XB_SPIN(xb_ld(&bar[XB_XGEN(b.x)]) == gen, bar);
            __builtin_amdgcn_fence(__ATOMIC_ACQUIRE, "agent");
            asm volatile("s_waitcnt vmcnt(0)" ::: "memory");
        }
    }
    __syncthreads();
}

struct Args { const float* in[32]; float* out; unsigned char* ws; int ph_lo, ph_hi; };
enum { I_X = 0, I_MEM, I_F1N, I_F1IN, I_F1OUT, I_MIXN, I_MIXIN, I_MIXOUT, I_CONVW, I_CONVB, I_LB, I_HGN, I_MU, I_W0, I_W2, I_A0, I_A2, I_G2, I_KK, I_KA, I_RK, I_LNW, I_LNB,
       I_XAN, I_MEMN, I_WQ, I_WKV, I_WO, I_F2N, I_F2IN, I_F2OUT, I_FINN };

__device__ __forceinline__ void transpose_item(const float* W, int N, int k0, int n0, const float* gain, float scale, bf16_t* WT, int ldk, int drow0, LAS float* scr, int lane) {
#pragma unroll
    for (int i = 0; i < 32; ++i) { const int kk = 2 * i + (lane >> 5); const float gk = gain ? gain[k0 + kk] * scale : scale;
        scr[kk * 33 + (lane & 31)] = W[(size_t)(k0 + kk) * N + n0 + (lane & 31)] * gk; }
    asm volatile("s_waitcnt lgkmcnt(0)" ::: "memory");
    const int c = lane & 7;
#pragma unroll
    for (int j = 0; j < 4; ++j) { const int n = (lane >> 3) + 8 * j; const LAS float* s = scr + (8 * c) * 33 + n;
        u32x4 o; o.x = pk2(s[0 * 33], s[1 * 33]); o.y = pk2(s[2 * 33], s[3 * 33]); o.z = pk2(s[4 * 33], s[5 * 33]); o.w = pk2(s[6 * 33], s[7 * 33]);
        *(u32x4*)(WT + (size_t)(drow0 + n) * ldk + k0 + 8 * c) = o; }
    asm volatile("s_waitcnt lgkmcnt(0)" ::: "memory");
}
__device__ __forceinline__ void conv_matrix_item(const float* W, int K, int N, const float* gain, float scale, bf16_t* WT, int mode, int item, LAS float* scr, int lane) {
    const int nblk = N / 32, kb = item / nblk, nb = item % nblk, k0 = 64 * kb, n0 = 32 * nb;
    int drow0 = n0;
    if (mode == 1) { const int up = n0 >= DFF, j0 = up ? n0 - DFF : n0; drow0 = 256 * (j0 / 128) + (j0 % 128) + (up ? 128 : 0); }
    transpose_item(W, N, k0, n0, gain, scale, WT, K, drow0, scr, lane);
}

__device__ __forceinline__ unsigned char* wbuf(const Args& a, int l) { return (l & 1) ? (unsigned char*)a.out + ((size_t)64 << 20) : a.ws; }
__device__ __forceinline__ void phase_convert_layer(const Args& a, LAS unsigned char* lds, int l, int first, int nblk) {
    const int tid = opaque_tid(), lane = tid & 63, wave = tid >> 6;
    LAS float* scr = (LAS float*)(lds + wave * 16384);
    const int gw = ((int)blockIdx.x - first) * 8 + wave, NGW = nblk * 8;
    unsigned char* ws = wbuf(a, l);
    constexpr int I_FIN = 16 * 176, I_FOUT = 44 * 32, I_MIN = 16 * 116, I_SQ = 16 * 32;
    constexpr int NITEMS = 2 * I_FIN + 2 * I_FOUT + I_MIN + 2 * I_SQ;
    for (int it = gw; it < NITEMS; it += NGW) {
        int r = it;
        if (r < I_FIN) { conv_matrix_item(a.in[I_F1IN] + (size_t)l * D * 2 * DFF, D, 2 * DFF, a.in[I_F1N] + l * D, 1.0f, (bf16_t*)(ws + W_FFN1_IN), 1, r, scr, lane); continue; } r -= I_FIN;
        if (r < I_FIN) { conv_matrix_item(a.in[I_F2IN] + (size_t)l * D * 2 * DFF, D, 2 * DFF, a.in[I_F2N] + l * D, 1.0f, (bf16_t*)(ws + W_FFN2_IN), 1, r, scr, lane); continue; } r -= I_FIN;
        if (r < I_FOUT) { conv_matrix_item(a.in[I_F1OUT] + (size_t)l * DFF * D, DFF, D, nullptr, 1.0f, (bf16_t*)(ws + W_FFN1_OUT), 0, r, scr, lane); continue; } r -= I_FOUT;
        if (r < I_FOUT) { conv_matrix_item(a.in[I_F2OUT] + (size_t)l * DFF * D, DFF, D, nullptr, 1.0f, (bf16_t*)(ws + W_FFN2_OUT), 0, r, scr, lane); continue; } r -= I_FOUT;
        if (r < I_MIN) { conv_matrix_item(a.in[I_MIXIN] + (size_t)l * D * INW, D, INW, a.in[I_MIXN] + l * D, 1.0f, (bf16_t*)(ws + W_MIX_IN), 0, r, scr, lane); continue; } r -= I_MIN;
        if (r < I_SQ) { conv_matrix_item(a.in[I_MIXOUT] + (size_t)l * D * D, D, D, nullptr, 1.0f, (bf16_t*)(ws + W_MIX_OUT), 0, r, scr, lane); continue; } r -= I_SQ;
        conv_matrix_item(a.in[I_WO] + (size_t)l * D * D, D, D, nullptr, 1.0f, (bf16_t*)(ws + W_O), 0, r, scr, lane);
    }
    {
        const float* wq = a.in[I_WQ] + (size_t)l * D * D; const float* gq = a.in[I_XAN] + l * D; bf16_t* wqn = (bf16_t*)(ws + W_Q);
        for (int idx = ((int)blockIdx.x - first) * 512 + tid; idx < D * D / 4; idx += nblk * 512) {
            const f32x4 v = *((const f32x4*)wq + idx) * (gq[idx >> 8] * 0.0625f);
            u32x2 w; w.x = pk2(v.x, v.y); w.y = pk2(v.z, v.w);
            *((u32x2*)wqn + idx) = w;
        }
    }
    bf16_t* lr = (bf16_t*)(ws + W_LR);
    const float* w2 = a.in[I_W2] + (size_t)l * 64 * 384; const float* a2 = a.in[I_A2] + (size_t)l * 64 * 384; const float* g2 = a.in[I_G2] + (size_t)l * 128 * 384;
    for (int idx = ((int)blockIdx.x - first) * 512 + tid; idx < LRWP * 256; idx += nblk * 512) {
        const int n = idx >> 8, k = idx & 255; float v = 0.f;
        if (n < 384) { if (k < 64) v = w2[k * 384 + n]; }
        else if (n < 768) { if (k >= 64 && k < 128) v = a2[(k - 64) * 384 + (n - 384)]; }
        else if (n < 1152) { if (k >= 128) v = g2[(k - 128) * 384 + (n - 768)]; }
        lr[idx] = (bf16_t)f2bf(v);
    }
}

__device__ __forceinline__ float lb_value(const float* lbl, int l, int c) {
    const float z0 = lbl[c], z1 = lbl[384 + c], z2 = lbl[768 + c], z3 = lbl[1152 + c];
    const float m = fmaxf(fmaxf(z0, z1), fmaxf(z2, z3));
    const float e0 = expf(z0 - m), e1 = expf(z1 - m), e2 = expf(z2 - m), e3 = expf(z3 - m);
    const float inv = 1.0f / ((e0 + e1) + (e2 + e3));
    float cs = 0.f;
    if (l >= 1) cs += e1 * inv;
    if (l >= 2) cs += e2 * inv;
    if (l >= 3) cs += e3 * inv;
    return fmaxf(cs, 0.f);
}
__device__ __forceinline__ void phase_setup(const Args& a, LAS unsigned char* lds) {
    const int tid = opaque_tid(), lane = tid & 63, wave = tid >> 6;
    const int gw = blockIdx.x * 8 + wave, NGW = gridDim.x * 8;
    unsigned char* ws = a.ws;
    bf16_t* hb = (bf16_t*)(ws + WS_HB); float* ssq = (float*)(ws + WS_SSQ);
    for (int row = gw; row < T; row += 2 * NGW) {
        const int row2 = (row + NGW < T) ? row + NGW : row;
        const f32x4* xr = (const f32x4*)(a.in[I_X] + (size_t)row * D) + lane;
        const f32x4* xr2 = (const f32x4*)(a.in[I_X] + (size_t)row2 * D) + lane;
        f32x4 v[4], v2[4];
#pragma unroll
        for (int j = 0; j < 4; ++j) { v[j] = xr[64 * j]; v2[j] = xr2[64 * j]; }
        u32x2* hbr = (u32x2*)(hb + (size_t)row * D) + lane;
        u32x2* hbr2 = (u32x2*)(hb + (size_t)row2 * D) + lane;
        float s = 0.f, s2 = 0.f;
#pragma unroll
        for (int j = 0; j < 4; ++j) {
            s += (v[j].x * v[j].x + v[j].y * v[j].y) + (v[j].z * v[j].z + v[j].w * v[j].w);
            s2 += (v2[j].x * v2[j].x + v2[j].y * v2[j].y) + (v2[j].z * v2[j].z + v2[j].w * v2[j].w);
            u32x2 w; w.x = pk2(v[j].x, v[j].y); w.y = pk2(v[j].z, v[j].w); hbr[64 * j] = w;
            u32x2 w2; w2.x = pk2(v2[j].x, v2[j].y); w2.y = pk2(v2[j].z, v2[j].w); hbr2[64 * j] = w2;
        }
        s = wave_sum(s); s2 = wave_sum(s2);
        if (lane < 4) { ssq[(size_t)row * 4 + lane] = (lane == 0) ? s : 0.f; ssq[(size_t)row2 * 4 + lane] = (lane == 0) ? s2 : 0.f; }
    }
    bf16_t* memh = (bf16_t*)(ws + WS_S1 + S1_MEMH);
    for (int row = gw; row < MT; row += NGW) {
        const f32x4* xr = (const f32x4*)(a.in[I_MEM] + (size_t)row * D) + lane;
        u32x2* o = (u32x2*)(memh + (size_t)row * D) + lane;
        f32x4 v[4]; float s = 0.f;
#pragma unroll
        for (int j = 0; j < 4; ++j) { v[j] = xr[64 * j]; s += (v[j].x * v[j].x + v[j].y * v[j].y) + (v[j].z * v[j].z + v[j].w * v[j].w); }
        const float rs = rsqrtf(wave_sum(s) * (1.0f / 1024.0f) + EPS);
#pragma unroll
        for (int j = 0; j < 4; ++j) { u32x2 w; w.x = pk2(v[j].x * rs, v[j].y * rs); w.y = pk2(v[j].z * rs, v[j].w * rs); o[64 * j] = w; }
    }
    if (blockIdx.x == 0) for (int i = tid; i < NL * 384; i += 512) ((float*)(ws + WS_LB))[i] = lb_value(a.in[I_LB], i / 384, i % 384);
    phase_convert_layer(a, lds, 0, 0, (int)gridDim.x);
    LAS float* scr = (LAS float*)(lds + wave * 16384);
    bf16_t* wkvT = (bf16_t*)(ws + WS_S1 + S1_WKV);
    constexpr int I_KV = 16 * 64;
    for (int it = gw; it < NL * I_KV; it += NGW) {
        const int l = it / I_KV, r = it % I_KV;
        conv_matrix_item(a.in[I_WKV] + (size_t)l * D * 2048, D, 2048, a.in[I_MEMN] + l * D, 1.0f, wkvT + (size_t)l * 2048 * D, 0, r, scr, lane);
    }
}

__device__ __forceinline__ void phase_prep(const Args& a, int l) {
    const int tid = opaque_tid(), lane = tid & 63, wave = tid >> 6;
    const int gw = blockIdx.x * 8 + wave, NGW = gridDim.x * 8;
    const bf16_t* p = (const bf16_t*)(a.ws + WS_S1); bf16_t* lrin = (bf16_t*)(a.ws + WS_LRIN);
    const f32x4 mu = *(const f32x4*)(a.in[I_MU] + (size_t)l * 1408 + 1152 + 4 * lane);
    for (int tk = gw; tk < T; tk += NGW) {
        const bf16_t* src = p + (size_t)tk * INW + PC_RW + 1152 + 4 * lane;
        const u32x2 c = *(const u32x2*)src;
        u32x2 pv = (u32x2){0u, 0u};
        if ((tk & (SEQ - 1)) != 0) pv = *(const u32x2*)(src - INW);
        float x[4] = {bflo(c.x), bfhi(c.x), bflo(c.y), bfhi(c.y)};
        const float xp[4] = {bflo(pv.x), bfhi(pv.x), bflo(pv.y), bfhi(pv.y)};
#pragma unroll
        for (int j = 0; j < 4; ++j) { x[j] = x[j] + (xp[j] - x[j]) * mu[j];
            if (lane < 16) x[j] = tanh_f(x[j]); else if (lane >= 32) x[j] = sigm(x[j]); }
        u32x2 w; w.x = pk2(x[0], x[1]); w.y = pk2(x[2], x[3]);
        *(u32x2*)(lrin + (size_t)tk * 256 + 4 * lane) = w;
    }
}

constexpr int CH = 32;
#define LDS_BARRIER() do { asm volatile("s_waitcnt lgkmcnt(0)" ::: "memory"); __builtin_amdgcn_s_barrier(); asm volatile("" ::: "memory"); } while (0)
__device__ __forceinline__ void scan_unit(const Args& a, LAS unsigned char* lds, int l, int b, int h, int qt) {
    const int tid = opaque_tid(), tok = tid >> 4, q = tid & 15, rl = (tid & 255) >> 4;
    const bool is_rw = __builtin_amdgcn_readfirstlane(tid >> 8) == 0;
    constexpr int oRA = 0, oRB = 2048, oRW = 4096, oRK = 6144, oRR = 8192, oRV = 10240, oHQ = 10752, oHK = 12800, oHV = 14848, oYR = 15360, oYH = 15872, BUFF = 16384;
    LAS float* L = (LAS float*)lds;
    const bf16_t* p = (const bf16_t*)(a.ws + WS_S1); const bf16_t* lr = (const bf16_t*)(a.ws + WS_LROUT); bf16_t* yraw = (bf16_t*)a.out;
    const float* mu = a.in[I_MU] + (size_t)l * 1408;
    const int c4 = h * 64 + 4 * q, cv = h * 64 + qt * 16 + q;
    const f32x4 mu_r = *(const f32x4*)(mu + c4), mu_k = *(const f32x4*)(mu + 384 + c4);
    const float mu_v = mu[768 + cv];
    const f32x4 kkp = *(const f32x4*)(a.in[I_KK] + l * 384 + c4), kap = *(const f32x4*)(a.in[I_KA] + l * 384 + c4);
    f32x2 S01 = (f32x2){0.f, 0.f}, S23 = (f32x2){0.f, 0.f};
    const bool up4 = __builtin_amdgcn_update_dpp(0, q, 0x124, 0xF, 0xF, true) == (q ^ 4);
    const size_t tb = (size_t)b * SEQ;
    u32x2 r_c, r_p, k_c, k_p, lw_c, a_c, q_c, z_c; bf16_t v_c, v_p, hv_c;
#define SC_LOAD(t0) do { const size_t tg = tb + (t0) + tok; const bf16_t* pr = p + tg * INW; \
        r_c = *(const u32x2*)(pr + PC_RW + c4); k_c = *(const u32x2*)(pr + PC_RW + 384 + c4); v_c = pr[PC_RW + 768 + cv]; \
        if ((t0) + tok != 0) { r_p = *(const u32x2*)(pr - INW + PC_RW + c4); k_p = *(const u32x2*)(pr - INW + PC_RW + 384 + c4); v_p = pr[PC_RW + 768 + cv - INW]; } \
        else { r_p = (u32x2){0u, 0u}; k_p = (u32x2){0u, 0u}; v_p = 0; } \
        lw_c = *(const u32x2*)(lr + tg * LRW + c4); a_c = *(const u32x2*)(lr + tg * LRW + 384 + c4); \
        q_c = *(const u32x2*)(pr + PC_HG + c4); z_c = *(const u32x2*)(pr + PC_HG + 384 + c4); hv_c = pr[PC_HG + 768 + cv]; } while (0)
#define SC_FILL(LB) do { \
        const float rc[4] = {bflo(r_c.x), bfhi(r_c.x), bflo(r_c.y), bfhi(r_c.y)}, rp[4] = {bflo(r_p.x), bfhi(r_p.x), bflo(r_p.y), bfhi(r_p.y)}; \
        const float kc[4] = {bflo(k_c.x), bfhi(k_c.x), bflo(k_c.y), bfhi(k_c.y)}, kp[4] = {bflo(k_p.x), bfhi(k_p.x), bflo(k_p.y), bfhi(k_p.y)}; \
        const float lw[4] = {bflo(lw_c.x), bfhi(lw_c.x), bflo(lw_c.y), bfhi(lw_c.y)}, av[4] = {bflo(a_c.x), bfhi(a_c.x), bflo(a_c.y), bfhi(a_c.y)}; \
        f32x4 rs, ks, kk, A, B, W, Kq; float n2 = 0.f; \
        _Pragma("unroll") for (int j = 0; j < 4; ++j) { rs[j] = rc[j] + (rp[j] - rc[j]) * mu_r[j]; ks[j] = kc[j] + (kp[j] - kc[j]) * mu_k[j]; kk[j] = ks[j] * kkp[j]; n2 += kk[j] * kk[j]; } \
        n2 = sum16(n2); \
        const float inv = rsqrtf(fmaxf(n2, 1e-24f)); \
        _Pragma("unroll") for (int j = 0; j < 4; ++j) { const float kn = kk[j] * inv; A[j] = -kn; B[j] = kn * av[j]; W[j] = __expf(lw[j]); Kq[j] = ks[j] * (1.0f + (av[j] - 1.0f) * kap[j]); } \
        *(LAS f32x4*)((LB) + oRA + tok * 64 + 4 * q) = A; *(LAS f32x4*)((LB) + oRB + tok * 64 + 4 * q) = B; *(LAS f32x4*)((LB) + oRW + tok * 64 + 4 * q) = W; \
        *(LAS f32x4*)((LB) + oRK + tok * 64 + 4 * q) = Kq; *(LAS f32x4*)((LB) + oRR + tok * 64 + 4 * q) = rs; \
        const float v0 = __uint_as_float((unsigned)v_c << 16), vp0 = __uint_as_float((unsigned)v_p << 16); \
        (LB)[oRV + tok * 16 + q] = v0 + (vp0 - v0) * mu_v; \
        const f32x4 Q = (f32x4){bflo(q_c.x), bfhi(q_c.x), bflo(q_c.y), bfhi(q_c.y)}, Kx = (f32x4){bflo(z_c.x), bfhi(z_c.x), bflo(z_c.y), bfhi(z_c.y)}; \
        *(LAS f32x4*)((LB) + oHQ + tok * 64 + 4 * q) = Q; *(LAS f32x4*)((LB) + oHK + tok * 64 + 4 * q) = Kx; \
        (LB)[oHV + tok * 16 + q] = __uint_as_float((unsigned)hv_c << 16); } while (0)
#define SC_WRITEOUT(cc) do { const LAS float* YB = L + ((cc) & 1) * BUFF; const int tk2 = (tid & 255) >> 3, pr2 = tid & 7; \
        const f32x2 yy = *(const LAS f32x2*)(YB + (is_rw ? oYR : oYH) + tk2 * 16 + 2 * pr2); \
        *(unsigned*)(yraw + (tb + (size_t)(cc) * CH + tk2) * 768 + (is_rw ? 384 : 0) + h * 64 + qt * 16 + 2 * pr2) = pk2(yy.x, yy.y); } while (0)
    constexpr int NCH = SEQ / CH;
    SC_LOAD(0);
    SC_FILL(L);
    SC_LOAD(CH);
    LDS_BARRIER();
    for (int c = 0; c < NCH; ++c) {
        LAS float* SB = L + (c & 1) * BUFF;
        if (c > 0) SC_WRITEOUT(c - 1);
        if (c + 1 < NCH) { LAS float* NB = L + ((c + 1) & 1) * BUFF; SC_FILL(NB); if (c + 2 < NCH) SC_LOAD((c + 2) * CH); }
        if (is_rw) {
            const LAS float* RA = SB + oRA + 4 * q; const LAS float* RV = SB + oRV + rl;
            f32x4 A = *(const LAS f32x4*)(RA), B = *(const LAS f32x4*)(RA + oRB), W = *(const LAS f32x4*)(RA + oRW);
            f32x4 Kq = *(const LAS f32x4*)(RA + oRK), R = *(const LAS f32x4*)(RA + oRR);
            float v = RV[0];
#pragma unroll 1
            for (int t0 = 0; t0 < CH; t0 += 16) {
                float yp[16];
#pragma unroll
                for (int i = 0; i < 16; ++i) {
                    const int tn = (t0 + i + 1) * 64;
                    const f32x4 nA = *(const LAS f32x4*)(RA + tn), nB = *(const LAS f32x4*)(RA + oRB + tn), nW = *(const LAS f32x4*)(RA + oRW + tn);
                    const f32x4 nK = *(const LAS f32x4*)(RA + oRK + tn), nR = *(const LAS f32x4*)(RA + oRR + tn);
                    const float nv = RV[(t0 + i + 1) * 16];
                    __builtin_amdgcn_sched_barrier(0);
                    f32x2 d = S01 * A.xy; d = S23 * A.zw + d;
                    const float sa = sum16(d.x + d.y);
                    const f32x2 vv = (f32x2){v, v}, sv = (f32x2){sa, sa};
                    const f32x2 t01 = S01 * W.xy + vv * Kq.xy, t23 = S23 * W.zw + vv * Kq.zw;
                    S01 = sv * B.xy + t01; S23 = sv * B.zw + t23;
                    f32x2 e = S01 * R.xy; e = S23 * R.zw + e;
                    yp[i] = e.x + e.y;
                    A = nA; B = nB; W = nW; Kq = nK; R = nR; v = nv;
                }
                SB[oYR + (t0 + q) * 16 + rl] = reduce_scatter16(yp, q, up4);
            }
        } else {
            const LAS float* HQ = SB + oHQ + 4 * q; const LAS float* HV = SB + oHV + rl;
            f32x4 Q = *(const LAS f32x4*)(HQ), Kx = *(const LAS f32x4*)(HQ + (oHK - oHQ));
            float v = HV[0];
#pragma unroll 1
            for (int t0 = 0; t0 < CH; t0 += 16) {
                float op[16];
#pragma unroll
                for (int i = 0; i < 16; ++i) {
                    const int tn = (t0 + i + 1) * 64;
                    const f32x4 nQ = *(const LAS f32x4*)(HQ + tn), nK = *(const LAS f32x4*)(HQ + (oHK - oHQ) + tn);
                    const float nv = HV[(t0 + i + 1) * 16];
                    __builtin_amdgcn_sched_barrier(0);
                    const f32x2 vv = (f32x2){v, v};
                    S01 = Kx.xy * (vv - S01) + S01; S23 = Kx.zw * (vv - S23) + S23;
                    f32x2 e = S01 * Q.xy; e = S23 * Q.zw + e;
                    op[i] = e.x + e.y;
                    Q = nQ; Kx = nK; v = nv;
                }
                SB[oYH + (t0 + q) * 16 + rl] = reduce_scatter16(op, q, up4);
            }
        }
        LDS_BARRIER();
    }
    SC_WRITEOUT(NCH - 1);
#undef SC_LOAD
#undef SC_FILL
#undef SC_WRITEOUT
    LDS_BARRIER();
}
__device__ __forceinline__ void phase_scan(const Args& a, LAS unsigned char* lds, int l) {
    for (int s = blockIdx.x; s < 192; s += gridDim.x) scan_unit(a, lds, l, s / 24, (s % 24) >> 2, s & 3);
    if (l + 1 < NL) {
        const int first = gridDim.x > 192 ? 192 : 0;
        if ((int)blockIdx.x >= first) phase_convert_layer(a, lds, l + 1, first, (int)gridDim.x - first);
    }
}

__device__ __forceinline__ f32x4 ld4bf(const bf16_t* p) { const u32x2 w = *(const u32x2*)p; return (f32x4){bflo(w.x), bfhi(w.x), bflo(w.y), bfhi(w.y)}; }
__device__ __forceinline__ void st4bf(bf16_t* p, f32x4 v) { u32x2 w; w.x = pk2(v.x, v.y); w.y = pk2(v.z, v.w); *(u32x2*)p = w; }
__device__ __forceinline__ f32x4 cvt4bf(u32x2 w) { return (f32x4){bflo(w.x), bfhi(w.x), bflo(w.y), bfhi(w.y)}; }
__device__ __forceinline__ void phase_post(const Args& a, int l) {
    const int tid = opaque_tid(), q = tid & 15, wave = __builtin_amdgcn_readfirstlane(tid >> 6), sub4 = (tid >> 4) & 3;
    const bf16_t* p = (const bf16_t*)(a.ws + WS_S1); const bf16_t* lr = (const bf16_t*)(a.ws + WS_LROUT); const bf16_t* yraw = (const bf16_t*)a.out;
    bf16_t* y = (bf16_t*)(a.ws + WS_YQ);
    const int it0 = blockIdx.x, nit = T / 2, dit = gridDim.x;
    const u32x2 Z = (u32x2){0u, 0u};
    if (wave < 2) {
        const int i = wave * 4 + sub4, sub = i >> 2, c = (i & 3) * 64 + 4 * q;
        const float* cw = a.in[I_CONVW] + (size_t)l * 768;
        const f32x4 w0 = *(const f32x4*)(cw + c), w1 = *(const f32x4*)(cw + 256 + c), w2 = *(const f32x4*)(cw + 512 + c), cb = *(const f32x4*)(a.in[I_CONVB] + l * 256 + c);
        u32x2 bg, c0, x0, c1, x1, c2, x2;
#define CV_LOAD(it) do { const int tk = 2 * (it) + sub, t = tk & (SEQ - 1); const bf16_t* pr = p + (size_t)tk * INW + c; \
            bg = *(const u32x2*)pr; c0 = *(const u32x2*)(pr + 256); x0 = *(const u32x2*)(pr + 512); \
            if (t >= 1) { c1 = *(const u32x2*)(pr - INW + 256); x1 = *(const u32x2*)(pr - INW + 512); } else { c1 = Z; x1 = Z; } \
            if (t >= 2) { c2 = *(const u32x2*)(pr - 2 * INW + 256); x2 = *(const u32x2*)(pr - 2 * INW + 512); } else { c2 = Z; x2 = Z; } } while (0)
        CV_LOAD(it0);
        for (int it = it0; it < nit; it += dit) {
            const f32x4 fb = cvt4bf(bg), z0 = cvt4bf(c0) * cvt4bf(x0), z1 = cvt4bf(c1) * cvt4bf(x1), z2 = cvt4bf(c2) * cvt4bf(x2);
            if (it + dit < nit) CV_LOAD(it + dit);
            st4bf(y + (size_t)(2 * it + sub) * D + c, fb * ((w0 * z2 + w1 * z1 + w2 * z0) + cb));
        }
#undef CV_LOAD
    } else if (wave < 5) {
        const int i = (wave - 2) * 4 + sub4, sub = i >= 6 ? 1 : 0, c = (i - 6 * sub) * 64 + 4 * q;
        const f32x4 hn = *(const f32x4*)(a.in[I_HGN] + l * 384 + c);
        u32x2 ro, rg;
#define HG_LOAD(it) do { const int tk = 2 * (it) + sub; ro = *(const u32x2*)(yraw + (size_t)tk * 768 + c); rg = *(const u32x2*)(p + (size_t)tk * INW + PC_HG + 1152 + c); } while (0)
        HG_LOAD(it0);
        for (int it = it0; it < nit; it += dit) {
            const f32x4 o = cvt4bf(ro), g = cvt4bf(rg);
            if (it + dit < nit) HG_LOAD(it + dit);
            const float ms = sum16((o.x * o.x + o.y * o.y) + (o.z * o.z + o.w * o.w)) * (1.0f / 64.0f);
            const float rs = rsqrtf(ms + EPS);
            st4bf(y + (size_t)(2 * it + sub) * D + 256 + c, o * rs * hn * g);
        }
#undef HG_LOAD
    } else {
        const int i = (wave - 5) * 4 + sub4, sub = i >= 6 ? 1 : 0, c = (i - 6 * sub) * 64 + 4 * q;
        const float* mu = a.in[I_MU] + (size_t)l * 1408;
        const f32x4 mur = *(const f32x4*)(mu + c), muk = *(const f32x4*)(mu + 384 + c), muv = *(const f32x4*)(mu + 768 + c);
        const f32x4 ka = *(const f32x4*)(a.in[I_KA] + l * 384 + c), rk = *(const f32x4*)(a.in[I_RK] + l * 384 + c);
        const f32x4 lnw = *(const f32x4*)(a.in[I_LNW] + l * 384 + c), lnb = *(const f32x4*)(a.in[I_LNB] + l * 384 + c);
        u32x2 ry, rr, rrp, rkk, rkp, rv, rvp, ra, rg;
#define RW_LOAD(it) do { const int tk = 2 * (it) + sub, t = tk & (SEQ - 1); const bf16_t* pr = p + (size_t)tk * INW + PC_RW + c; \
            ry = *(const u32x2*)(yraw + (size_t)tk * 768 + 384 + c); rr = *(const u32x2*)pr; rkk = *(const u32x2*)(pr + 384); rv = *(const u32x2*)(pr + 768); \
            if (t >= 1) { rrp = *(const u32x2*)(pr - INW); rkp = *(const u32x2*)(pr - INW + 384); rvp = *(const u32x2*)(pr - INW + 768); } else { rrp = Z; rkp = Z; rvp = Z; } \
            ra = *(const u32x2*)(lr + (size_t)tk * LRW + 384 + c); rg = *(const u32x2*)(lr + (size_t)tk * LRW + 768 + c); } while (0)
        RW_LOAD(it0);
        for (int it = it0; it < nit; it += dit) {
            const f32x4 yv = cvt4bf(ry), av = cvt4bf(ra), g = cvt4bf(rg);
            f32x4 r = cvt4bf(rr), k = cvt4bf(rkk), v = cvt4bf(rv);
            r = r + (cvt4bf(rrp) - r) * mur; k = k + (cvt4bf(rkp) - k) * muk; v = v + (cvt4bf(rvp) - v) * muv;
            if (it + dit < nit) RW_LOAD(it + dit);
            float s1 = (yv.x + yv.y) + (yv.z + yv.w), bs = 0.f;
#pragma unroll
            for (int jj = 0; jj < 4; ++jj) bs += r[jj] * (k[jj] * (1.0f + (av[jj] - 1.0f) * ka[jj])) * rk[jj];
            sum16x2(s1, bs);
            const f32x4 d = yv - s1 * (1.0f / 64.0f);
            const float var = sum16((d.x * d.x + d.y * d.y) + (d.z * d.z + d.w * d.w)) * (1.0f / 64.0f);
            const float rs = rsqrtf(var + 64e-5f);
            st4bf(y + (size_t)(2 * it + sub) * D + 640 + c, ((d * rs * lnw + lnb) + v * bs) * g);
        }
#undef RW_LOAD
    }
}

__device__ __forceinline__ void phase_final(const Args& a) {
    const int tid = opaque_tid(), lane = tid & 63, wave = tid >> 6;
    const int gw = blockIdx.x * 8 + wave, NGW = gridDim.x * 8;
    const bf16_t* hb = (const bf16_t*)(a.ws + WS_HB);
    const f32x4* gn = (const f32x4*)(a.in[I_FINN]) + lane;
    const f32x4 g0 = gn[0], g1 = gn[64], g2 = gn[128], g3 = gn[192];
    for (int row = gw; row < T; row += 2 * NGW) {
        const int row2 = (row + NGW < T) ? row + NGW : row;
        const u32x2* hr = (const u32x2*)(hb + (size_t)row * D) + lane;
        const u32x2* hr2 = (const u32x2*)(hb + (size_t)row2 * D) + lane;
        u32x2 w[4], w2[4];
#pragma unroll
        for (int j = 0; j < 4; ++j) { w[j] = hr[64 * j]; w2[j] = hr2[64 * j]; }
        f32x4 v[4], v2[4]; float s = 0.f, s2 = 0.f;
#pragma unroll
        for (int j = 0; j < 4; ++j) {
            v[j] = (f32x4){bflo(w[j].x), bfhi(w[j].x), bflo(w[j].y), bfhi(w[j].y)}; v2[j] = (f32x4){bflo(w2[j].x), bfhi(w2[j].x), bflo(w2[j].y), bfhi(w2[j].y)};
            s += (v[j].x * v[j].x + v[j].y * v[j].y) + (v[j].z * v[j].z + v[j].w * v[j].w);
            s2 += (v2[j].x * v2[j].x + v2[j].y * v2[j].y) + (v2[j].z * v2[j].z + v2[j].w * v2[j].w);
        }
        const float rs = rsqrtf(wave_sum(s) * (1.0f / 1024.0f) + EPS), rs2 = rsqrtf(wave_sum(s2) * (1.0f / 1024.0f) + EPS);
        f32x4* orow = (f32x4*)(a.out + (size_t)row * D) + lane;
        f32x4* orow2 = (f32x4*)(a.out + (size_t)row2 * D) + lane;
        orow[0] = v[0] * rs * g0; orow[64] = v[1] * rs * g1; orow[128] = v[2] * rs * g2; orow[192] = v[3] * rs * g3;
        orow2[0] = v2[0] * rs2 * g0; orow2[64] = v2[1] * rs2 * g1; orow2[128] = v2[2] * rs2 * g2; orow2[192] = v2[3] * rs2 * g3;
    }
}

#ifdef DIS_MISC
#define MISC(x) do {} while (0)
#else
#define MISC(x) x
#endif
enum { K_NONE = 0, K_BF16, K_SWIGLU, K_RESID, K_LOWRANK, K_SOFTMAX, K_MEMKV };
__global__ void __launch_bounds__(512) mk_fwd(Args a) {
    extern __shared__ __attribute__((aligned(16))) unsigned char lds_raw[];
    LAS unsigned char* lds = (LAS unsigned char*)lds_raw;
    cg::grid_group grid = cg::this_grid();
    unsigned char* ws = a.ws;
    float* ssq = (float*)(ws + WS_SSQ);
    bf16_t* hb = (bf16_t*)(ws + WS_HB);
    if (threadIdx.x < 2) ((volatile LAS unsigned*)(lds + LDS_MISC))[threadIdx.x] = 0u;
    __syncthreads();
    const XcdBarrier xbar = xcd_barrier_post((unsigned*)(ws + WS_CTL), (volatile LAS unsigned*)(lds + LDS_MISC));
    for (int ph = a.ph_lo; ph < a.ph_hi; ++ph) {
      const int kk = (ph >= 2 && ph < NPH - 1) ? (ph - 2) % 12 : -1;
      const int nrep = (kk == 5) ? 2 : ((DUP_K >= 0 && kk == DUP_K) ? 2 : 1);
      for (int rep = 0; rep < nrep; ++rep) {
        int kind = K_NONE;
        Gemm g; g.A = nullptr; g.Bt = nullptr; g.M = T; g.N = D; g.K = D; g.lda = D; g.ldb = D;
        g.aHi = 0xffffffffu; g.aLo = 0; g.aPn = 0; g.bPn = 0xffffffffu; g.bHi = 0; g.bLo = 0; g.aSh = 0; g.aMsk = 0; g.bSh = 0; g.bMsk = 0;
        bf16_t* o1 = nullptr; int ldc = D, ncols = D, emode = 0; const float* rs_ssq = nullptr; float alpha = 1.0f;
        int l = 0, sG = (int)gridDim.x, sC = (int)blockIdx.x;
#ifdef DIS_MISC
        if (ph == 0) { }
#else
        if (ph == 0) { phase_setup(a, lds); }
#endif
        else if (ph == 1) {
            kind = K_MEMKV; g.A = (const bf16_t*)(ws + WS_S1 + S1_MEMH); g.Bt = (const bf16_t*)(ws + WS_S1 + S1_WKV); g.M = MT; g.N = 8192;
#ifdef DIS_MISC
        } else if (ph == NPH - 1) { }
#else
        } else if (ph == NPH - 1) { phase_final(a); }
#endif
        else {
            l = (ph - 2) / 12; const int k = kk;
            const unsigned char* wb = wbuf(a, l);
            bf16_t* Mt = (bf16_t*)(ws + WS_LRIN);
            bf16_t* PWt = (bf16_t*)((unsigned char*)a.out + ((size_t)112 << 20));
            switch (k) {
            case 0: case 10: kind = K_SWIGLU; g.A = hb; g.Bt = (const bf16_t*)(wb + (k == 0 ? W_FFN1_IN : W_FFN2_IN)); g.N = 2 * DFF; o1 = (bf16_t*)(ws + WS_S1); break;
            case 1: case 11: kind = K_RESID; g.A = (const bf16_t*)(ws + WS_S1); g.Bt = (const bf16_t*)(wb + (k == 1 ? W_FFN1_OUT : W_FFN2_OUT)); g.K = DFF; g.lda = DFF; g.ldb = DFF; alpha = 0.5f; break;
            case 2: kind = K_BF16; g.A = hb; g.Bt = (const bf16_t*)(wb + W_MIX_IN); g.N = INWP; o1 = (bf16_t*)(ws + WS_S1); ldc = INW; ncols = INW; rs_ssq = ssq; emode = 1; break;
            case 3: MISC(phase_prep(a, l)); break;
            case 4: kind = K_LOWRANK; g.A = (const bf16_t*)(ws + WS_LRIN); g.Bt = (const bf16_t*)(wb + W_LR); g.N = LRWP; g.K = 256; g.lda = 256; g.ldb = 256; break;
            case 5: {
                if (rep == 0) { MISC(phase_scan(a, lds, l)); __syncthreads(); }
                const int first = gridDim.x > 192 ? 192 : 0;
                if ((int)blockIdx.x >= first) {
                    kind = K_BF16; sG = (int)gridDim.x - first; sC = (int)blockIdx.x - first;
                    g.M = 8192; g.N = D; g.K = 256;
                    if (rep == 0) { g.A = (const bf16_t*)(ws + WS_KALL) + (size_t)l * MT * D; g.Bt = (const bf16_t*)(wb + W_Q); o1 = Mt;
                                    g.aSh = 2; g.aHi = 256u * D; g.aMsk = 3; g.aLo = 256; g.bPn = 256u * D; g.bMsk = 3; g.bLo = 256; }
                    else          { g.A = (const bf16_t*)(wb + W_O); g.Bt = (const bf16_t*)(ws + WS_VT) + (size_t)l * MT * D; o1 = PWt;
                                    g.aHi = 0; g.aMsk = 3; g.aLo = 256u * D; g.aPn = 256; g.bPn = 256; g.bSh = 2; g.bHi = 256u * D; }
                }
            } break;
            case 6: MISC(phase_post(a, l)); break;
            case 7: kind = K_RESID; g.A = (const bf16_t*)(ws + WS_YQ); g.Bt = (const bf16_t*)(wb + W_MIX_OUT); break;
            case 8: kind = K_SOFTMAX; g.A = hb; g.Bt = Mt; g.bPn = 256u * D; g.bSh = 4; g.bHi = 4u * 256 * D; break;
            case 9: kind = K_RESID; g.A = (const bf16_t*)(ws + WS_S1); g.Bt = PWt; g.bPn = 256u * D; g.bSh = 4; g.bHi = (unsigned)(D * D); break;
            }
        }
        if (g.aHi == 0xffffffffu) g.aHi = (unsigned)(BM * g.lda);
        if (g.bPn == 0xffffffffu) g.bPn = (unsigned)(BM * g.ldb);
        if (kind != K_NONE) {
            Sched S; S.init(g.M, g.N, sG, sC);
            switch (kind) {
#ifndef DIS_K_BF16
            case K_BF16: { EpiBf16S E; E.O = o1; E.ldc = ldc; E.ncols = ncols; E.ssq = rs_ssq; E.mode = emode; E.lb = (const float*)(ws + WS_LB) + l * 384; gemm_phase(lds, g, S, E); } break;
#endif
#ifndef DIS_K_SWIGLU
            case K_SWIGLU: { EpiSwiglu E; E.O = o1; E.ssq = ssq; gemm_phase(lds, g, S, E); } break;
#endif
#ifndef DIS_K_RESID
            case K_RESID: { EpiResid E; E.hb = hb; E.ssq = ssq; E.lds = lds; E.alpha = (rep == 0) ? alpha : 0.0f; gemm_phase(lds, g, S, E); } break;
#endif
#ifndef DIS_K_LOWRANK
            case K_LOWRANK: { EpiLowrank E; E.O = (bf16_t*)(ws + WS_LROUT); E.w0 = a.in[I_W0] + l * 384; E.a0 = a.in[I_A0] + l * 384; gemm_phase(lds, g, S, E); } break;
#endif
#ifndef DIS_K_SOFTMAX
            case K_SOFTMAX: { EpiSoftmax E; E.O = (bf16_t*)(ws + WS_S1); E.lds = lds; E.ssq = ssq; gemm_phase(lds, g, S, E); } break;
#endif
#ifndef DIS_K_MEMKV
            case K_MEMKV: { EpiMemKV E; E.Kall = (bf16_t*)(ws + WS_KALL); E.Vall = (bf16_t*)(ws + WS_VT); gemm_phase(lds, g, S, E); } break;
#endif
            }
        }
      }
        if (ph + 1 < a.ph_hi) { if (ph == a.ph_lo) grid.sync(); else xcd_barrier(xbar); if (DUP_SYNC) xcd_barrier(xbar); }
    }
}

extern "C" void kernel_launch(void* const* d_in, const int* in_sizes, int n_in, void* d_out, int out_size, void* d_ws, size_t ws_size, hipStream_t stream) {
    static int grid = 0;
    if (grid == 0) {
        if (n_in != 32 || out_size != T * D || ws_size < WS_END) { fprintf(stderr, "kernel_launch: unexpected shapes (n_in %d out %d ws %zu need %zu)\n", n_in, out_size, ws_size, (size_t)WS_END); grid = -1; return; }
        int dev = 0, cus = 0, per_cu = 0;
        hipGetDevice(&dev);
        hipDeviceGetAttribute(&cus, hipDeviceAttributeMultiprocessorCount, dev);
        hipFuncSetAttribute((const void*)mk_fwd, hipFuncAttributeMaxDynamicSharedMemorySize, LDS_BYTES);
        hipOccupancyMaxActiveBlocksPerMultiprocessor(&per_cu, (const void*)mk_fwd, 512, LDS_BYTES);
        if (per_cu < 1) per_cu = 1;
        grid = cus * per_cu;
        (void)hipGetLastError();
    }
    if (grid < 0) return;
    if (hipMemsetAsync((char*)d_ws + WS_CTL, 0, CTL_BYTES, stream) != hipSuccess) { fprintf(stderr, "kernel_launch: memset failed\n"); return; }
    Args a{};
    for (int i = 0; i < 32; ++i) a.in[i] = (const float*)d_in[i];
    a.out = (float*)d_out; a.ws = (unsigned char*)d_ws;
#if MK_PER_PHASE_LAUNCH
    for (int ph = 0; ph < NPH; ++ph) {
        a.ph_lo = ph; a.ph_hi = ph + 1;
        void* args[] = {&a};
        hipError_t e = hipLaunchCooperativeKernel((const void*)mk_fwd, dim3(grid), dim3(512), args, LDS_BYTES, stream);
        if (e != hipSuccess) { fprintf(stderr, "launch of phase %d failed: %s\n", ph, hipGetErrorString(e)); break; }
    }
#else
    a.ph_lo = 0; a.ph_hi = NPH;
    void* args[] = {&a};
    hipError_t e = hipLaunchCooperativeKernel((const void*)mk_fwd, dim3(grid), dim3(512), args, LDS_BYTES, stream);
    if (e != hipSuccess) fprintf(stderr, "cooperative launch failed: %s (grid %d)\n", hipGetErrorString(e), grid);
#endif
}
```
